# Optimizing an MI355X kernel written in HIP

```python
import math
import jax, jax.numpy as jnp
from jax import lax
import numpy as np

D_MODEL = 1024
BATCH = 8
SEQ = 4096
DEPTH = 1

HEAD_DIM = 64
DILATIONS = (1, 4, 16)
KEYS_PER_QUERY = 128
WINDOWS = tuple(KEYS_PER_QUERY * d for d in DILATIONS)
N_GROUPS = len(DILATIONS)
HEADS_PER_GROUP = 4
ATT_HEADS = N_GROUPS * HEADS_PER_GROUP
ATT_WIDTH = ATT_HEADS * HEAD_DIM
ATT_OUT_WIDTH = HEADS_PER_GROUP * HEAD_DIM
QUERY_BLOCK = 64
N_BUCKETS = 32
MAX_DISTANCE = WINDOWS[-1]
RWKV_HEADS = D_MODEL // HEAD_DIM
RWKV_WIDTH = RWKV_HEADS * HEAD_DIM
DECAY_LORA = 64
ICLR_LORA = 64
GATE_LORA = 128
RWKV_COLS = 3 * RWKV_WIDTH + DECAY_LORA + ICLR_LORA + GATE_LORA
N_BRANCHES = 2
IN_COLS = 3 * ATT_WIDTH + RWKV_COLS + N_BRANCHES * D_MODEL
D_FF = 4 * D_MODEL
NORM_EPS = 1e-6
LN_X_EPS = 64e-5
L2_EPS = 1e-12

kernel_name = "hybrid_dilated_attn_rwkv7_gated_block"


def rmsnorm(x, g):
    xf = x.astype(jnp.float32)
    y = xf * lax.rsqrt(jnp.mean(xf * xf, axis=-1, keepdims=True) + NORM_EPS)
    return (y * g.astype(jnp.float32)).astype(x.dtype)


def t5_bucket(dist):
    max_exact = N_BUCKETS // 2
    d_f = jnp.maximum(dist, 1).astype(jnp.float32)
    large = max_exact + (jnp.log(d_f / max_exact) / math.log(MAX_DISTANCE / max_exact)
                         * (N_BUCKETS - max_exact)).astype(jnp.int32)
    large = jnp.minimum(large, N_BUCKETS - 1)
    return jnp.where(dist < max_exact, dist, large)


def dilated_window_attention(q, k, v, rel_bias):
    b, s = q.shape[0], q.shape[1]
    dil = jnp.array(DILATIONS, jnp.int32)
    dist = dil[:, None] * jnp.arange(KEYS_PER_QUERY + 1, dtype=jnp.int32)[None, :]
    bucket = t5_bucket(dist)
    bias = rel_bias.reshape(N_BUCKETS, N_GROUPS, HEADS_PER_GROUP)[bucket, jnp.arange(N_GROUPS)[:, None]]
    bias = jnp.transpose(bias, (0, 2, 1)).astype(jnp.float32)
    qg = jnp.moveaxis(q, 2, 0)
    kg = jnp.moveaxis(k, 2, 0)
    vg = jnp.moveaxis(v, 2, 0)
    scale = HEAD_DIM ** -0.5

    def one_block(blk):
        start = blk * QUERY_BLOCK
        t = start + jnp.arange(QUERY_BLOCK, dtype=jnp.int32)
        pos = t[None, :, None] - dist[:, None, :]
        valid = pos >= 0
        pos = jnp.maximum(pos, 0)
        qb = lax.dynamic_slice_in_dim(qg, start, QUERY_BLOCK, axis=2)
        kb = jax.vmap(lambda a, p: a[:, p])(kg, pos)
        vb = jax.vmap(lambda a, p: a[:, p])(vg, pos)
        logits = jnp.einsum('gbqhd,gbqjhd->gbhqj', qb, kb,
                            preferred_element_type=jnp.float32) * scale
        logits = logits + bias[:, None, :, None, :]
        logits = jnp.where(valid[:, None, None, :, :], logits, -jnp.inf)
        lse = jax.nn.logsumexp(logits, axis=-1)
        p = jnp.exp(logits - lse[..., None])
        o = jnp.einsum('gbhqj,gbqjhd->gbqhd', p, vb.astype(jnp.float32))
        w_mix = jax.nn.softmax(lse, axis=0)
        o = jnp.einsum('gbhq,gbqhd->bqhd', w_mix, o)
        return o.astype(v.dtype)

    out = lax.map(one_block, jnp.arange(s // QUERY_BLOCK, dtype=jnp.int32))
    return jnp.moveaxis(out, 0, 1).reshape(b, s, ATT_OUT_WIDTH)


def token_shift(f, mu):
    f_prev = jnp.pad(f, ((0, 0), (1, 0), (0, 0)))[:, :-1]
    return f + (f_prev - f) * mu


def rwkv7_time_mix(f, w0, w_w2, a0, w_a2, w_g2, k_k, k_a, r_k, ln_w, ln_b):
    b, s, _ = f.shape
    splits = [RWKV_WIDTH, 2 * RWKV_WIDTH, 3 * RWKV_WIDTH,
              3 * RWKV_WIDTH + DECAY_LORA, 3 * RWKV_WIDTH + DECAY_LORA + ICLR_LORA]
    r, k, v, fw, fa, fg = jnp.split(f, splits, axis=-1)
    w = -jax.nn.softplus(-(w0 + jnp.tanh(fw) @ w_w2)) - 0.5
    decay = jnp.exp(-jnp.exp(w.astype(jnp.float32)))
    a = jax.nn.sigmoid(a0 + fa @ w_a2)
    g = jax.nn.sigmoid(fg) @ w_g2
    kk = (k * k_k).reshape(b, s, RWKV_HEADS, HEAD_DIM).astype(jnp.float32)
    kk = kk / jnp.maximum(jnp.linalg.norm(kk, axis=-1, keepdims=True), L2_EPS)
    k = k * (1 + (a - 1) * k_a)
    heads = lambda t: t.reshape(b, s, RWKV_HEADS, HEAD_DIM).astype(jnp.float32)
    r, k, v, decay, a = heads(r), heads(k), heads(v), heads(decay), heads(a)

    def step(state, inp):
        r_t, w_t, k_t, v_t, kk_t, a_t = inp
        sa = jnp.einsum('bhij,bhj->bhi', state, -kk_t)
        state = (state * w_t[:, :, None, :]
                 + sa[..., None] * (kk_t * a_t)[:, :, None, :]
                 + v_t[..., None] * k_t[:, :, None, :])
        y_t = jnp.einsum('bhij,bhj->bhi', state, r_t)
        return state, y_t

    xs = tuple(jnp.moveaxis(t, 1, 0) for t in (r, decay, k, v, kk, a))
    state0 = jnp.zeros((b, RWKV_HEADS, HEAD_DIM, HEAD_DIM), jnp.float32)
    _, y = lax.scan(step, state0, xs)
    y = jnp.moveaxis(y, 0, 1)
    mu = jnp.mean(y, axis=-1, keepdims=True)
    var = jnp.mean(jnp.square(y - mu), axis=-1, keepdims=True)
    y = ((y - mu) * lax.rsqrt(var + LN_X_EPS)).reshape(b, s, RWKV_WIDTH)
    y = y * ln_w.astype(jnp.float32) + ln_b.astype(jnp.float32)
    bonus = jnp.sum(r * k * r_k.astype(jnp.float32), axis=-1, keepdims=True) * v
    y = (y + bonus.reshape(b, s, RWKV_WIDTH)) * g.astype(jnp.float32)
    return y.astype(f.dtype)


def setup_inputs(seed: int = 0) -> dict:
    key = jax.random.key(seed)
    ks = jax.random.split(key, 32)
    L = DEPTH
    nrm = lambda k, shape, scale: jax.random.normal(k, shape, jnp.float32) * scale
    gain = lambda k, shape: 1.0 + 0.05 * jax.random.normal(k, shape, jnp.float32)
    return {
        "x": nrm(ks[0], (BATCH, SEQ, D_MODEL), 1.0),
        "rel_bias": nrm(ks[1], (N_BUCKETS, ATT_HEADS), 0.2),
        "norm_mix_pre": gain(ks[2], (L, D_MODEL)),
        "norm_mix_post": gain(ks[3], (L, D_MODEL)),
        "norm_ffn_pre": gain(ks[4], (L, D_MODEL)),
        "norm_ffn_post": gain(ks[5], (L, D_MODEL)),
        "w_in": nrm(ks[6], (L, D_MODEL, IN_COLS), D_MODEL ** -0.5),
        "b_gate": nrm(ks[7], (L, N_BRANCHES * D_MODEL), 0.02),
        "shift_mu": jax.random.uniform(ks[8], (L, RWKV_COLS), jnp.float32),
        "w0": jax.random.uniform(ks[9], (L, RWKV_WIDTH), jnp.float32, -6.0, 1.0),
        "w_w2": nrm(ks[10], (L, DECAY_LORA, RWKV_WIDTH), 0.1 * DECAY_LORA ** -0.5),
        "a0": nrm(ks[11], (L, RWKV_WIDTH), 0.1),
        "w_a2": nrm(ks[12], (L, ICLR_LORA, RWKV_WIDTH), 0.5 * ICLR_LORA ** -0.5),
        "w_g2": nrm(ks[13], (L, GATE_LORA, RWKV_WIDTH), GATE_LORA ** -0.5),
        "k_k": 0.85 + 0.05 * jax.random.normal(ks[14], (L, RWKV_WIDTH), jnp.float32),
        "k_a": gain(ks[15], (L, RWKV_WIDTH)),
        "r_k": nrm(ks[16], (L, RWKV_HEADS, HEAD_DIM), 0.1),
        "ln_x_w": gain(ks[17], (L, RWKV_WIDTH)),
        "ln_x_b": nrm(ks[18], (L, RWKV_WIDTH), 0.02),
        "w_att_branch": nrm(ks[19], (L, ATT_OUT_WIDTH, D_MODEL), ATT_OUT_WIDTH ** -0.5),
        "w_rwkv_branch": nrm(ks[20], (L, RWKV_WIDTH, D_MODEL), RWKV_WIDTH ** -0.5),
        "w_out": nrm(ks[21], (L, D_MODEL, D_MODEL), D_MODEL ** -0.5),
        "w_ffn1": nrm(ks[22], (L, D_MODEL, D_FF), D_MODEL ** -0.5),
        "w_ffn2": nrm(ks[23], (L, D_FF, D_MODEL), D_FF ** -0.5),
    }


def reference(x, rel_bias, norm_mix_pre, norm_mix_post, norm_ffn_pre, norm_ffn_post,
              w_in, b_gate, shift_mu, w0, w_w2, a0, w_a2, w_g2, k_k, k_a, r_k,
              ln_x_w, ln_x_b, w_att_branch, w_rwkv_branch, w_out, w_ffn1, w_ffn2):
    b, s, _ = x.shape
    for l in range(DEPTH):
        h = rmsnorm(x, norm_mix_pre[l])
        proj = h @ w_in[l]
        f_att, f_rwkv, f_gate = jnp.split(
            proj, [3 * ATT_WIDTH, 3 * ATT_WIDTH + RWKV_COLS], axis=-1)
        qkv = f_att.reshape(b, s, 3, N_GROUPS, HEADS_PER_GROUP, HEAD_DIM)
        o_att = dilated_window_attention(qkv[:, :, 0], qkv[:, :, 1], qkv[:, :, 2], rel_bias)
        o_rwkv = rwkv7_time_mix(token_shift(f_rwkv, shift_mu[l]), w0[l], w_w2[l], a0[l],
                                w_a2[l], w_g2[l], k_k[l], k_a[l], r_k[l],
                                ln_x_w[l], ln_x_b[l])
        gates = jax.nn.sigmoid(f_gate + b_gate[l]).reshape(b, s, N_BRANCHES, D_MODEL)
        merged = (gates[:, :, 0] * (o_att @ w_att_branch[l])
                  + gates[:, :, 1] * (o_rwkv @ w_rwkv_branch[l]))
        x = x + rmsnorm(merged @ w_out[l], norm_mix_post[l])
        h = rmsnorm(x, norm_ffn_pre[l])
        ff = jnp.square(jax.nn.relu(h @ w_ffn1[l])) @ w_ffn2[l]
        x = x + rmsnorm(ff, norm_ffn_post[l])
    return x
```

```cpp
#include <hip/hip_runtime.h>
#include <cstdio>
#include <cstdint>
#include <cmath>
namespace pg8 {
#define PG8_LAS __attribute__((address_space(3)))
typedef unsigned short bf16_t;
typedef short bf16x8 __attribute__((ext_vector_type(8)));
typedef float f32x4 __attribute__((ext_vector_type(4)));
typedef unsigned u32x4 __attribute__((ext_vector_type(4)));
constexpr int BM = 256, BK = 64, HALF = 128, HTB = HALF * BK * 2  , STAGE_BYTES = 8 * HTB, NXCD = 8, WGM = 8;

__host__ __device__ __forceinline__ int lds_byte(int r, int c) { const int st = (r >> 4) * 2 + (c >> 5), rr = r & 15, cc = c & 31, ob = rr * 64 + cc * 2; return st * 1024 + (ob ^ (((ob >> 9) & 1) << 5)); }
__host__ __device__ __forceinline__ void stage_rc(int b, int& R, int& C) { const int st = b / 1024, sb = b % 1024, swz = sb ^ (((sb >> 9) & 1) << 5); R = (st >> 1) * 16 + swz / 64; C = (st & 1) * 32 + (swz % 64) / 2; }
__host__ __device__ __forceinline__ int perm32(int rho) { const int n = rho >> 4, i = rho & 15; return 8 * (i >> 2) + 4 * n + (i & 3); }

struct Unit { int pm, pn; };
struct Gemm { const bf16_t* A; const bf16_t* Bt; int M, N, K; };

struct StaticOrder {
    int nM, nN, nwg, G, c;
    __host__ __device__ void init(int M, int N, int G_, int c_) { nM = M / BM; nN = N / BM; nwg = nM * nN; G = G_; c = c_; }
    __host__ __device__ bool next(int i, Unit& u) const {
        const long L = (long)i * G + c; if (L >= nwg) return false;
        int wgid = (int)L; { const int q = nwg / NXCD, r = nwg % NXCD, xcd = wgid % NXCD, off = wgid / NXCD; wgid = (xcd < r ? xcd * (q + 1) : r * (q + 1) + (xcd - r) * q) + off; }
        const int nig = WGM * nN, gid = wgid / nig, fm = gid * WGM, gsz = (nM - fm) < WGM ? (nM - fm) : WGM;
        u.pm = fm + ((wgid % nig) % gsz); u.pn = (wgid % nig) / gsz; return true;
    }
    __device__ __forceinline__ void a_ready(const Unit&) const {}
    __device__ __forceinline__ void done(const Unit&) const {}
};

__device__ __forceinline__ unsigned cvt_pk_bf16(float lo, float hi) { unsigned r; asm volatile("v_cvt_pk_bf16_f32 %0, %1, %2" : "=v"(r) : "v"(lo), "v"(hi)); return r; }
typedef float f32x2 __attribute__((ext_vector_type(2)));
__device__ __forceinline__ float bf2f(unsigned short b) { return __uint_as_float(((unsigned)b) << 16); }
__device__ __forceinline__ float sigm_fast(float x) { return __builtin_amdgcn_rcpf(1.0f + __builtin_amdgcn_exp2f(-1.4426950408889634f * x)); }
__device__ __forceinline__ f32x4 unpack_lo4(unsigned a, unsigned b) { return (f32x4){__uint_as_float(a << 16), __uint_as_float(a & 0xffff0000u), __uint_as_float(b << 16), __uint_as_float(b & 0xffff0000u)}; }

struct EpiProj {
    static constexpr bool PERM = true, AFTER_DRAIN = false;
    bf16_t* QKV; bf16_t* F; bf16_t* GATE; const float* b_gate; float qscale;
    __device__ __forceinline__ void operator()(const f32x4 (&acc)[2][2][4][2], const Unit& u, int wr, int wc, int fr, int fq) const {
        const int row0 = u.pm * BM + wr * 64 + fr; const int pn = u.pn;
        bf16_t* base; int ldc, colt, mode;
        if (pn < 9) { base = QKV; ldc = 2304; colt = pn * 256; mode = pn < 3 ? 1 : 0; }
        else if (pn < 22) { base = F; ldc = 3328; colt = (pn - 9) * 256; mode = 0; }
        else { base = GATE; ldc = 2048; colt = (pn - 22) * 256; mode = 2; }
        const int col0 = colt + wc * 32 + 8 * fq;
        f32x4 bv[2][2];
#pragma unroll
        for (int bj = 0; bj < 2; ++bj)
#pragma unroll
            for (int n = 0; n < 2; ++n) bv[bj][n] = (mode == 2) ? *(const f32x4*)(b_gate + col0 + bj * HALF + 4 * n) : (f32x4){0.f, 0.f, 0.f, 0.f};
        const float sc = (mode == 1) ? qscale : 1.0f;
#pragma unroll
        for (int ai = 0; ai < 2; ++ai)
#pragma unroll
            for (int m = 0; m < 4; ++m) { bf16_t* rowp = base + (size_t)(row0 + ai * HALF + m * 16) * ldc + col0;
#pragma unroll
                for (int bj = 0; bj < 2; ++bj) { f32x4 v0 = (acc[ai][bj][m][0] + bv[bj][0]) * sc, v1 = (acc[ai][bj][m][1] + bv[bj][1]) * sc;
                    if (mode == 2) { v0 = (f32x4){sigm_fast(v0[0]), sigm_fast(v0[1]), sigm_fast(v0[2]), sigm_fast(v0[3])}; v1 = (f32x4){sigm_fast(v1[0]), sigm_fast(v1[1]), sigm_fast(v1[2]), sigm_fast(v1[3])}; }
                    u32x4 w; w.x = cvt_pk_bf16(v0[0], v0[1]); w.y = cvt_pk_bf16(v0[2], v0[3]); w.z = cvt_pk_bf16(v1[0], v1[1]); w.w = cvt_pk_bf16(v1[2], v1[3]);
                    *(u32x4*)(rowp + bj * HALF) = w; } }
    }
};
struct EpiGateF32 {
    static constexpr bool PERM = false, AFTER_DRAIN = false;
    float* TMP; const bf16_t* GATE; int goff;
    __device__ __forceinline__ void operator()(const f32x4 (&acc)[2][2][4][2], const Unit& u, int wr, int wc, int fr, int fq) const {
        const int row0 = u.pm * BM + wr * 64 + fr, col0 = u.pn * BM + wc * 32 + 4 * fq;
#pragma unroll
        for (int ai = 0; ai < 2; ++ai)
#pragma unroll
            for (int m = 0; m < 4; ++m) { const size_t r = (size_t)(row0 + ai * HALF + m * 16);
#pragma unroll
                for (int bj = 0; bj < 2; ++bj)
#pragma unroll
                    for (int n = 0; n < 2; ++n) { const int c = col0 + bj * HALF + n * 16;
                        const unsigned long long g = *(const unsigned long long*)(GATE + r * 2048 + goff + c);
                        const f32x4 gv = unpack_lo4((unsigned)g, (unsigned)(g >> 32));
                        *(f32x4*)(TMP + r * 1024 + c) = acc[ai][bj][m][n] * gv; }
                asm volatile("" ::: "memory"); }
    }
};
struct EpiMerge {
    static constexpr bool PERM = true, AFTER_DRAIN = false;
    bf16_t* OUT; const float* TMP; const bf16_t* GATE; int goff;
    __device__ __forceinline__ void operator()(const f32x4 (&acc)[2][2][4][2], const Unit& u, int wr, int wc, int fr, int fq) const {
        const int row0 = u.pm * BM + wr * 64 + fr, col0 = u.pn * BM + wc * 32 + 8 * fq;
#pragma unroll
        for (int ai = 0; ai < 2; ++ai)
#pragma unroll
            for (int m = 0; m < 4; ++m) { const size_t r = (size_t)(row0 + ai * HALF + m * 16);
#pragma unroll
                for (int bj = 0; bj < 2; ++bj) { const int c = col0 + bj * HALF;
                    const u32x4 g = *(const u32x4*)(GATE + r * 2048 + goff + c);
                    const f32x4 t0 = *(const f32x4*)(TMP + r * 1024 + c), t1 = *(const f32x4*)(TMP + r * 1024 + c + 4);
                    const f32x4 v0 = acc[ai][bj][m][0] * unpack_lo4(g.x, g.y) + t0, v1 = acc[ai][bj][m][1] * unpack_lo4(g.z, g.w) + t1;
                    u32x4 w; w.x = cvt_pk_bf16(v0[0], v0[1]); w.y = cvt_pk_bf16(v0[2], v0[3]); w.z = cvt_pk_bf16(v1[0], v1[1]); w.w = cvt_pk_bf16(v1[2], v1[3]);
                    *(u32x4*)(OUT + r * 1024 + c) = w; }
                asm volatile("" ::: "memory"); }
    }
};
struct EpiRelu2 {
    static constexpr bool PERM = true, AFTER_DRAIN = false;
    bf16_t* O; int ldc;
    __device__ __forceinline__ void operator()(const f32x4 (&acc)[2][2][4][2], const Unit& u, int wr, int wc, int fr, int fq) const {
        const int row0 = u.pm * BM + wr * 64 + fr, col0 = u.pn * BM + wc * 32 + 8 * fq;
#pragma unroll
        for (int ai = 0; ai < 2; ++ai)
#pragma unroll
            for (int m = 0; m < 4; ++m) { bf16_t* rowp = O + (size_t)(row0 + ai * HALF + m * 16) * ldc + col0;
#pragma unroll
                for (int bj = 0; bj < 2; ++bj) { f32x4 v0 = acc[ai][bj][m][0], v1 = acc[ai][bj][m][1];
#pragma unroll
                    for (int e = 0; e < 4; ++e) { const float a = fmaxf(v0[e], 0.f), b = fmaxf(v1[e], 0.f); v0[e] = a * a; v1[e] = b * b; }
                    u32x4 w; w.x = cvt_pk_bf16(v0[0], v0[1]); w.y = cvt_pk_bf16(v0[2], v0[3]); w.z = cvt_pk_bf16(v1[0], v1[1]); w.w = cvt_pk_bf16(v1[2], v1[3]);
                    *(u32x4*)(rowp + bj * HALF) = w; } }
    }
};
struct EpiF32 {
    static constexpr bool PERM = false, AFTER_DRAIN = false;
    float* C; int ldc;
    __device__ __forceinline__ void operator()(const f32x4 (&acc)[2][2][4][2], const Unit& u, int wr, int wc, int fr, int fq) const {
        const int row0 = u.pm * BM + wr * 64 + fr, col0 = u.pn * BM + wc * 32 + 4 * fq;
#pragma unroll
        for (int ai = 0; ai < 2; ++ai)
#pragma unroll
            for (int m = 0; m < 4; ++m) { float* rowp = C + (size_t)(row0 + ai * HALF + m * 16) * ldc + col0;
#pragma unroll
                for (int bj = 0; bj < 2; ++bj)
#pragma unroll
                    for (int n = 0; n < 2; ++n) *(f32x4*)(rowp + bj * HALF + n * 16) = acc[ai][bj][m][n]; }
    }
};

template <class Epi, class Sched, bool ALIGN_EPI = false, bool SP2 = false>
__device__ __forceinline__ void gemm_phase(PG8_LAS unsigned char* lds, const Gemm g, const Sched& S, const Epi& E) {
    const int tid = threadIdx.x, wid = __builtin_amdgcn_readfirstlane(tid >> 6), lane = tid & 63, wr = wid >> 2, wc = wid & 3, fr = lane & 15, fq = lane >> 4;
    const int K = g.K, nt = K / BK;
    unsigned voffA[2], voffB[2];
#pragma unroll
    for (int i = 0; i < 2; ++i) { int R, C; stage_rc(tid * 16 + i * 8192, R, C); const int Rb = Epi::PERM ? ((R & ~31) + perm32(R & 31)) : R;
        voffA[i] = (unsigned)(R * K + C) * 2u; voffB[i] = (unsigned)(Rb * K + C) * 2u; }
    const size_t kstep = (size_t)(BK * 2);
    const size_t hstep = (size_t)HALF * K * 2;
    const size_t tstep = 2 * hstep;
    const unsigned ldsw = (unsigned)wid * 1024u;
    const int aoff = lds_byte(wr * 64 + fr, fq * 8), boff = lds_byte(wc * 32 + fr, fq * 8);
#define PG8_SA(b, h) (((b) * 2 + (h)) * HTB)
#define PG8_SB(b, h) ((4 + (b) * 2 + (h)) * HTB)
#define PG8_STAGE(bufoff, gbase, voff) do { _Pragma("unroll") for (int _i = 0; _i < 2; ++_i) \
        __builtin_amdgcn_global_load_lds((const unsigned*)((const char*)(gbase) + (voff)[_i]), (PG8_LAS unsigned*)(lds + (bufoff) + ldsw + _i * 8192), 16, 0, 0); } while (0)
#define PG8_LDA(dst, b, h) do { _Pragma("unroll") for (int m = 0; m < 4; ++m) _Pragma("unroll") for (int k = 0; k < 2; ++k) dst[m][k] = *(const PG8_LAS bf16x8*)(lds + PG8_SA(b, h) + aoff + m * 2048 + k * 1024); } while (0)
#define PG8_LDB(dst, b, h) do { _Pragma("unroll") for (int n = 0; n < 2; ++n) _Pragma("unroll") for (int k = 0; k < 2; ++k) dst[n][k] = *(const PG8_LAS bf16x8*)(lds + PG8_SB(b, h) + boff + n * 2048 + k * 1024); } while (0)
#define PG8_MMA(ai, bj, At, Bt) do { __builtin_amdgcn_s_setprio(1); _Pragma("unroll") for (int m = 0; m < 4; ++m) _Pragma("unroll") for (int n = 0; n < 2; ++n) _Pragma("unroll") for (int k = 0; k < 2; ++k) \
        acc[ai][bj][m][n] = __builtin_amdgcn_mfma_f32_16x16x32_bf16(Bt[n][k], At[m][k], acc[ai][bj][m][n], 0, 0, 0); __builtin_amdgcn_s_setprio(0); } while (0)
#define PG8_WAIT_V(n) asm volatile("s_waitcnt vmcnt(" #n ")" ::: "memory")
#define PG8_WAIT_L(n) asm volatile("s_waitcnt lgkmcnt(" #n ")" ::: "memory")
#define PG8_BAR __builtin_amdgcn_s_barrier()
#define PG8_SCHED __builtin_amdgcn_sched_barrier(0)
    Unit cur, nxt; int ui = 0;
    if (!S.next(0, cur)) return;
    f32x4 acc[2][2][4][2];
#pragma unroll
    for (int a = 0; a < 2; ++a)
#pragma unroll
        for (int b = 0; b < 2; ++b)
#pragma unroll
            for (int m = 0; m < 4; ++m)
#pragma unroll
                for (int n = 0; n < 2; ++n) acc[a][b][m][n] = (f32x4){0.f, 0.f, 0.f, 0.f};
    bf16x8 At[4][2], B0[2][2], B1[2][2];
    const char* cA = (const char*)g.A + (size_t)cur.pm * tstep; const char* cB = (const char*)g.Bt + (size_t)cur.pn * tstep;
    S.a_ready(cur);
    if constexpr (SP2) {
        PG8_STAGE(PG8_SB(0, 0), cB, voffB); PG8_STAGE(PG8_SB(0, 1), cB + hstep, voffB); PG8_STAGE(PG8_SA(0, 0), cA, voffA); PG8_STAGE(PG8_SA(0, 1), cA + hstep, voffA);
        if (wr == 1) PG8_BAR;
        PG8_WAIT_V(2); PG8_BAR;
        PG8_STAGE(PG8_SB(1, 0), cB + kstep, voffB); PG8_STAGE(PG8_SA(1, 0), cA + kstep, voffA); PG8_STAGE(PG8_SB(1, 1), cB + hstep + kstep, voffB);
        PG8_WAIT_V(6); PG8_BAR;
    } else {
        PG8_STAGE(PG8_SB(0, 0), cB, voffB); PG8_STAGE(PG8_SA(0, 0), cA, voffA); PG8_STAGE(PG8_SB(0, 1), cB + hstep, voffB); PG8_STAGE(PG8_SA(0, 1), cA + hstep, voffA);
        if (wr == 1) PG8_BAR;
        PG8_WAIT_V(4); PG8_BAR;
        PG8_STAGE(PG8_SB(1, 0), cB + kstep, voffB); PG8_STAGE(PG8_SA(1, 0), cA + kstep, voffA); PG8_STAGE(PG8_SB(1, 1), cB + hstep + kstep, voffB);
        PG8_WAIT_V(6); PG8_BAR;
    }
    for (;;) {
        const bool has_next = S.next(ui + 1, nxt);
        const char* nA = has_next ? (const char*)g.A + (size_t)nxt.pm * tstep : cA; const char* nB = has_next ? (const char*)g.Bt + (size_t)nxt.pn * tstep : cB;
        for (int t = 0; t < nt; t += 2) {
            const bool last = (t == nt - 2);
            const char* a1 = cA + (size_t)(t + 1) * kstep;
            const char* a2 = last ? nA : cA + (size_t)(t + 2) * kstep; const char* b2 = last ? nB : cB + (size_t)(t + 2) * kstep;
            const char* a3 = a2 + kstep; const char* b3 = b2 + kstep;
            if (last && has_next) S.a_ready(nxt);
            if constexpr (SP2) {
            PG8_LDB(B0, 0, 0); PG8_LDB(B1, 0, 1); PG8_SCHED; PG8_LDA(At, 0, 0); PG8_STAGE(PG8_SA(1, 1), a1 + hstep, voffA);
            PG8_WAIT_V(8); PG8_WAIT_L(0); PG8_BAR; PG8_MMA(0, 0, At, B0); PG8_MMA(0, 1, At, B1); PG8_BAR; PG8_SCHED;
            PG8_LDA(At, 0, 1); PG8_STAGE(PG8_SB(0, 0), b2, voffB); PG8_STAGE(PG8_SB(0, 1), b2 + hstep, voffB); PG8_STAGE(PG8_SA(0, 0), a2, voffA);
            PG8_WAIT_V(8); PG8_WAIT_L(0); PG8_BAR; PG8_MMA(1, 0, At, B0); PG8_MMA(1, 1, At, B1); PG8_BAR; PG8_SCHED;
            PG8_LDB(B0, 1, 0); PG8_LDB(B1, 1, 1); PG8_SCHED; PG8_LDA(At, 1, 0); PG8_STAGE(PG8_SA(0, 1), a2 + hstep, voffA);
            PG8_WAIT_V(8); PG8_WAIT_L(0); PG8_BAR; PG8_MMA(0, 0, At, B0); PG8_MMA(0, 1, At, B1); PG8_BAR; PG8_SCHED;
            PG8_LDA(At, 1, 1); PG8_STAGE(PG8_SB(1, 0), b3, voffB); PG8_STAGE(PG8_SB(1, 1), b3 + hstep, voffB); PG8_STAGE(PG8_SA(1, 0), a3, voffA);
            PG8_WAIT_V(8); PG8_WAIT_L(0); PG8_BAR; PG8_MMA(1, 0, At, B0); PG8_MMA(1, 1, At, B1); PG8_BAR; PG8_SCHED;
            } else {
            PG8_LDB(B0, 0, 0); PG8_SCHED; PG8_LDA(At, 0, 0); PG8_STAGE(PG8_SA(1, 1), a1 + hstep, voffA);
            PG8_WAIT_L(8); PG8_BAR; PG8_WAIT_L(0); PG8_MMA(0, 0, At, B0); PG8_BAR; PG8_SCHED;
            PG8_LDB(B1, 0, 1); PG8_STAGE(PG8_SB(0, 0), b2, voffB);
            PG8_BAR; PG8_WAIT_L(0); PG8_MMA(0, 1, At, B1); PG8_BAR;
            PG8_LDA(At, 0, 1); PG8_STAGE(PG8_SA(0, 0), a2, voffA);
            PG8_BAR; PG8_WAIT_L(0); PG8_MMA(1, 0, At, B0); PG8_BAR; PG8_SCHED;
            PG8_STAGE(PG8_SB(0, 1), b2 + hstep, voffB);
            PG8_WAIT_V(6); PG8_BAR; PG8_MMA(1, 1, At, B1); PG8_BAR;
            PG8_LDB(B0, 1, 0); PG8_SCHED; PG8_LDA(At, 1, 0); PG8_STAGE(PG8_SA(0, 1), a2 + hstep, voffA);
            PG8_WAIT_L(8); PG8_BAR; PG8_WAIT_L(0); PG8_MMA(0, 0, At, B0); PG8_BAR; PG8_SCHED;
            PG8_LDB(B1, 1, 1); PG8_STAGE(PG8_SB(1, 0), b3, voffB);
            PG8_BAR; PG8_WAIT_L(0); PG8_MMA(0, 1, At, B1); PG8_BAR;
            PG8_LDA(At, 1, 1); PG8_STAGE(PG8_SA(1, 0), a3, voffA);
            PG8_BAR; PG8_WAIT_L(0); PG8_MMA(1, 0, At, B0); PG8_BAR; PG8_SCHED;
            PG8_STAGE(PG8_SB(1, 1), b3 + hstep, voffB);
            PG8_WAIT_V(6); PG8_BAR; PG8_MMA(1, 1, At, B1); PG8_BAR;
            }
        }
        if constexpr (ALIGN_EPI) { if (wr == 0) PG8_BAR; }
        if constexpr (!Epi::AFTER_DRAIN) { E(acc, cur, wr, wc, fr, fq); S.done(cur); }
        if (!has_next) break;
#pragma unroll
        for (int a = 0; a < 2; ++a)
#pragma unroll
            for (int b = 0; b < 2; ++b)
#pragma unroll
                for (int m = 0; m < 4; ++m)
#pragma unroll
                    for (int n = 0; n < 2; ++n) acc[a][b][m][n] = (f32x4){0.f, 0.f, 0.f, 0.f};
        cur = nxt; cA = nA; cB = nB; ++ui;
        if constexpr (ALIGN_EPI) { if (wr == 1) PG8_BAR; }
    }
    PG8_WAIT_V(0);
    if constexpr (!ALIGN_EPI) { if (wr == 0) PG8_BAR; }
    PG8_BAR;
    if constexpr (Epi::AFTER_DRAIN) { E.fused(acc, cur, wr, wc, fr, fq, lds, wid, lane); S.done(cur); }
#undef PG8_SA
#undef PG8_SB
#undef PG8_STAGE
#undef PG8_LDA
#undef PG8_LDB
#undef PG8_MMA
#undef PG8_WAIT_V
#undef PG8_WAIT_L
#undef PG8_BAR
#undef PG8_SCHED
}
}
constexpr int NWAVES = 8;
constexpr int BATCH = 8, SEQ = 4096, D = 1024, M = BATCH * SEQ;
constexpr int NQKV = 2304, NF = 3328, NG = 2048, NIN = 7680, FF = 4096, AO = 256;
constexpr float NORM_EPS = 1e-6f, LNX_EPS = 64e-5f, LOG2E = 1.4426950408889634f;
constexpr float QSCALE = 0.125f * LOG2E;
constexpr int NIN_T = 24;
constexpr size_t KiB = 1024, MiB = 1u << 20;
constexpr size_t WS_CTL = 0, CTL_ZERO_BYTES = 1 * MiB;
constexpr size_t WS_SMALL = 1 * MiB;
constexpr size_t WS_WIN = 2 * MiB;
constexpr size_t WS_WA = 17 * MiB;
constexpr size_t WS_WR = 17 * MiB + 512 * KiB;
constexpr size_t WS_WO = 19 * MiB + 512 * KiB;
constexpr size_t WS_W1 = 21 * MiB + 512 * KiB;
constexpr size_t WS_W2 = 29 * MiB + 512 * KiB;
constexpr size_t WS_XN = 38 * MiB;
constexpr size_t WS_QKV = 102 * MiB;
constexpr size_t WS_F = 246 * MiB;
constexpr size_t WS_OATT = 454 * MiB;
constexpr size_t WS_TMP = WS_QKV;
constexpr size_t WS_MERGED = WS_F;
constexpr size_t WS_Z = 310 * MiB;
constexpr size_t WS_H = 102 * MiB;
constexpr size_t WS_Z2 = 358 * MiB;
constexpr size_t WS_END = 512 * MiB;
static_assert(WS_Z2 + (size_t)M * D * 4 <= WS_END && WS_H + (size_t)M * FF * 2 <= WS_Z2 && WS_Z + (size_t)M * D * 4 <= WS_OATT && WS_OATT + (size_t)M * AO * 2 <= WS_END, "ws map");
constexpr int CW_BAR = 4096;
constexpr int RING_OFF = 0, RING_BYTES = 131072;
constexpr int LDSCTL_OFF = RING_BYTES, MISC_OFF = LDSCTL_OFF + 320;
constexpr int VEC_OFF = RING_BYTES + 1024;
constexpr int LDS_BYTES = 147456;

#define GAS __attribute__((address_space(1)))
#define LAS __attribute__((address_space(3)))
typedef unsigned short bf16;
typedef unsigned v4u __attribute__((ext_vector_type(4)));
typedef float f32x4 __attribute__((ext_vector_type(4)));
typedef short bf16x8 __attribute__((ext_vector_type(8)));
typedef GAS unsigned gu32;
typedef GAS unsigned long long gu64;
#define RLX_AGENT __ATOMIC_RELAXED, __HIP_MEMORY_SCOPE_AGENT
#define LDS_WAIT() asm volatile("s_waitcnt lgkmcnt(0)" ::: "memory")
#define VM_WAIT() asm volatile("s_waitcnt vmcnt(0)" ::: "memory")
__device__ __forceinline__ unsigned long long rt() { return __builtin_amdgcn_s_memrealtime(); }
__device__ __forceinline__ unsigned f2bf(float f) { unsigned u = __builtin_bit_cast(unsigned, f); return (u + 0x7fffu + ((u >> 16) & 1u)) >> 16; }
__device__ __forceinline__ unsigned pk2(float lo, float hi) { return f2bf(lo) | (f2bf(hi) << 16); }

#define XB_TMO      128
#define XB_XCNT(j)  (256  + 64 * (j))
#define XB_XSUB(j)  (1280 + 64 * (j))
#define XB_XGEN(j)  (2304 + 64 * (j))
#define XB_TOP      3328
#define XB_TOPGEN   3392
#define XCD_BAR_WORDS 3456
#define XB_SPIN_CAP (1u << 18)

__device__ __forceinline__ unsigned xb_ld(unsigned* p)              { return __hip_atomic_load(p, __ATOMIC_RELAXED, __HIP_MEMORY_SCOPE_AGENT); }
__device__ __forceinline__ unsigned xb_add(unsigned* p, unsigned v) { return __hip_atomic_fetch_add(p, v, __ATOMIC_RELAXED, __HIP_MEMORY_SCOPE_AGENT); }
__device__ __forceinline__ unsigned xb_xcc_id() { return (unsigned)__builtin_amdgcn_s_getreg((3 << 11) | 20) & 0xFu; }
#define XB_SPIN(cond, bar) do { unsigned _sp = 0; while (cond) { __builtin_amdgcn_s_sleep(1); \
    if ((++_sp & 255u) == 0u) { if (xb_ld(&(bar)[XB_TMO])) break; if (_sp > XB_SPIN_CAP) { atomicAdd(&(bar)[XB_TMO], 1u); break; } } } } while (0)

struct XcdBarrier {
    unsigned* bar; unsigned x;
    volatile LAS unsigned* st;
};

__device__ __forceinline__ XcdBarrier xcd_barrier_post(unsigned* bar, volatile LAS unsigned* st) {
    XcdBarrier b; b.bar = bar; b.x = xb_xcc_id(); b.st = st;
    if (threadIdx.x == 0) (void)xb_add(&bar[XB_XCNT(b.x)], 1u);
    return b;
}
__device__ __forceinline__ void xcd_barrier_complete(unsigned* bar, unsigned x, unsigned& nloc, unsigned& nx) {
    const unsigned G = gridDim.x * gridDim.y * gridDim.z;
    unsigned sum, cnt, mine, sp = 0u;
    for (;;) {
        sum = 0u; cnt = 0u; mine = 0u;
#pragma unroll
        for (unsigned j = 0; j < 16; ++j) { const unsigned c = xb_ld(&bar[XB_XCNT(j)]); sum += c; cnt += (c > 0u) ? 1u : 0u; mine = (j == x) ? c : mine; }
        if (sum == G) break;
        __builtin_amdgcn_s_sleep(1);
        if ((++sp & 255u) == 0u) { if (xb_ld(&bar[XB_TMO])) break; if (sp > XB_SPIN_CAP) { atomicAdd(&bar[XB_TMO], 1u); break; } }
    }
    nloc = mine > 0u ? mine : 1u; nx = cnt > 0u ? cnt : 1u;
}

__device__ __forceinline__ void xcd_barrier(const XcdBarrier& b) {
    asm volatile("s_waitcnt vmcnt(0)" ::: "memory");
    __syncthreads();
    if (threadIdx.x == 0) {
        unsigned* bar = b.bar;
        __builtin_amdgcn_s_waitcnt(0);
        unsigned nloc = b.st[0], nx = b.st[1];
        if (nloc == 0u) { xcd_barrier_complete(bar, b.x, nloc, nx); b.st[0] = nloc; b.st[1] = nx; }
        const unsigned old = xb_add(&bar[XB_XSUB(b.x)], 1u);
        const unsigned gen = old / nloc;
        if (old + 1u == (gen + 1u) * nloc) {
            __builtin_amdgcn_fence(__ATOMIC_RELEASE, "agent");
            asm volatile("s_waitcnt vmcnt(0)" ::: "memory");
            const unsigned og = xb_add(&bar[XB_TOP], 1u);
            const unsigned tg = og / nx;
            if (og + 1u == (tg + 1u) * nx) xb_add(&bar[XB_TOPGEN], 1u);
            else XB_SPIN(xb_ld(&bar[XB_TOPGEN]) == tg, bar);
            __builtin_amdgcn_fence(__ATOMIC_ACQUIRE, "agent");
            xb_add(&bar[XB_XGEN(b.x)], 1u);
            asm volatile("s_waitcnt vmcnt(0)" ::: "memory");
        } else {
            XB_SPIN(xb_ld(&bar[XB_XGEN(b.x)]) == gen, bar);
            __builtin_amdgcn_fence(__ATOMIC_ACQUIRE, "agent");
            asm volatile("s_waitcnt vmcnt(0)" ::: "memory");
        }
    }
    __syncthreads();
}
struct Frame {
    LAS unsigned char* lds;
    volatile LAS unsigned* MISC;
    gu32* ctl;
    int tid, lane, wave;
    int vcu, G;
};
struct Args { const float* in[NIN_T]; float* out; unsigned char* ws; };
__device__ __forceinline__ float wave_sum(float v) {
#pragma unroll
    for (int o = 1; o < 64; o <<= 1) v += __shfl_xor(v, o);
    return v;
}
__device__ __forceinline__ float wave_max(float v) {
#pragma unroll
    for (int o = 1; o < 64; o <<= 1) v = fmaxf(v, __shfl_xor(v, o));
    return v;
}
__device__ __forceinline__ float bf2f(unsigned short b) { return __uint_as_float(((unsigned)b) << 16); }
__device__ __forceinline__ unsigned short f2bf16(float f) { return (unsigned short)f2bf(f); }

__device__ __forceinline__ void p0_transpose_item(const float* W, int K, int N, bf16* WT, int row_off, LAS float* scr, int item, int lane) {
    const int nblk = N / 32, kb = item / nblk, nb = item % nblk, k0 = 64 * kb, n0 = 32 * nb;
#pragma unroll 8
    for (int i = 0; i < 32; ++i) { const int kk = 2 * i + (lane >> 5); scr[kk * 33 + (lane & 31)] = W[(size_t)(k0 + kk) * N + n0 + (lane & 31)]; }
    LDS_WAIT(); asm volatile("" ::: "memory");
    const int c = lane & 7;
#pragma unroll
    for (int j = 0; j < 4; ++j) { const int n = (lane >> 3) + 8 * j; const LAS float* s = scr + (8 * c) * 33 + n;
        v4u o; o.x = pk2(s[0 * 33], s[1 * 33]); o.y = pk2(s[2 * 33], s[3 * 33]); o.z = pk2(s[4 * 33], s[5 * 33]); o.w = pk2(s[6 * 33], s[7 * 33]);
        *(GAS v4u*)(WT + (size_t)(row_off + n0 + n) * K + k0 + 8 * c) = o; }
    LDS_WAIT(); asm volatile("" ::: "memory");
}
__device__ __forceinline__ void rms_row_to_bf16(int lane, const float* xrow, const float* g, bf16* orow) {
    const GAS f32x4* xr = (const GAS f32x4*)xrow + lane; const GAS f32x4* gr = (const GAS f32x4*)g + lane;
    f32x4 v[4]; float s = 0.f;
#pragma unroll
    for (int j = 0; j < 4; ++j) { v[j] = xr[64 * j]; s += (v[j].x * v[j].x + v[j].y * v[j].y) + (v[j].z * v[j].z + v[j].w * v[j].w); }
    const float rs = 1.0f / sqrtf(wave_sum(s) * (1.f / D) + NORM_EPS);
    GAS unsigned long long* o8 = (GAS unsigned long long*)orow + lane;
#pragma unroll
    for (int j = 0; j < 4; ++j) { const f32x4 gg = gr[64 * j];
        o8[64 * j] = (unsigned long long)pk2(v[j].x * rs * gg.x, v[j].y * rs * gg.y) | ((unsigned long long)pk2(v[j].z * rs * gg.z, v[j].w * rs * gg.w) << 32); }
}
__device__ __forceinline__ void p0_prologue(Frame& F, const Args& A) {
    LAS float* scr = (LAS float*)(F.lds + RING_OFF + F.wave * 16384);
    const int gw = F.vcu * NWAVES + F.wave, NGW = F.G * NWAVES;
    bf16* WinT = (bf16*)(A.ws + WS_WIN); bf16* WaT = (bf16*)(A.ws + WS_WA); bf16* WrT = (bf16*)(A.ws + WS_WR); bf16* WoT = (bf16*)(A.ws + WS_WO);
    bf16* W1T = (bf16*)(A.ws + WS_W1); bf16* W2T = (bf16*)(A.ws + WS_W2);
    constexpr int I_IN = (D / 64) * (NIN / 32), I_A = (AO / 64) * (D / 32), I_R = (D / 64) * (D / 32), I_O = I_R, I_1 = (D / 64) * (FF / 32), I_2 = (FF / 64) * (D / 32);
    constexpr int NITEMS = I_IN + I_A + I_R + I_O + I_1 + I_2;
    for (int it = gw; it < NITEMS; it += NGW) {
        int r = it;
        if (r < I_IN) { p0_transpose_item(A.in[6], D, NIN, WinT, 0, scr, r, F.lane); continue; } r -= I_IN;
        if (r < I_A) { p0_transpose_item(A.in[19], AO, D, WaT, 0, scr, r, F.lane); continue; } r -= I_A;
        if (r < I_R) { p0_transpose_item(A.in[20], D, D, WrT, 0, scr, r, F.lane); continue; } r -= I_R;
        if (r < I_O) { p0_transpose_item(A.in[21], D, D, WoT, 0, scr, r, F.lane); continue; } r -= I_O;
        if (r < I_1) { p0_transpose_item(A.in[22], D, FF, W1T, 0, scr, r, F.lane); continue; } r -= I_1;
        p0_transpose_item(A.in[23], FF, D, W2T, 0, scr, r, F.lane);
    }
    bf16* XN = (bf16*)(A.ws + WS_XN);
    for (int m = gw; m < M; m += NGW) rms_row_to_bf16(F.lane, A.in[0] + (size_t)m * D, A.in[2], XN + (size_t)m * D);
    if (blockIdx.x == 0) {
        float* bt = (float*)(A.ws + WS_SMALL);
        for (int idx = F.tid; idx < 3 * 4 * 129; idx += NWAVES * 64) {
            const int g = idx / (4 * 129), hh = (idx / 129) % 4, j = idx % 129; const int dist = j << (2 * g);
            int bucket;
            if (dist < 16) bucket = dist;
            else { const float df = (float)dist; int large = 16 + (int)(logf(df / 16.0f) / 4.852030263919617f * 16.0f); bucket = large < 31 ? large : 31; }
            bt[idx] = A.in[1][bucket * 12 + g * 4 + hh] * LOG2E;
        }
    }
}

__device__ __forceinline__ void attn_naive(Frame& F, const Args& A, int wslot, int nwslots) {
    const bf16* QKV = (const bf16*)(A.ws + WS_QKV); bf16* OATT = (bf16*)(A.ws + WS_OATT); const float* bt = (const float*)(A.ws + WS_SMALL);
    const int lane = F.lane;
    for (int task = wslot; task < M * 4; task += nwslots) {
        const int bt_ = task >> 2, hh = task & 3, b = bt_ >> 12, t = bt_ & 4095;
        float m = -INFINITY, l = 0.f, acc = 0.f;
        for (int g = 0; g < 3; ++g) {
            const int head = g * 4 + hh, dsh = 2 * g;
            const float qv = bf2f(QKV[(size_t)bt_ * NQKV + head * 64 + lane]);
            float s[3];
#pragma unroll
            for (int rnd = 0; rnd < 3; ++rnd) {
                const int j = lane + 64 * rnd; const int pos = t - (j << dsh); const bool valid = (j <= 128) && (pos >= 0);
                const int posc = valid ? pos : t;
                const GAS v4u* kp = (const GAS v4u*)(QKV + (size_t)(b * SEQ + posc) * NQKV + 768 + head * 64);
                float dot = 0.f;
#pragma unroll
                for (int c = 0; c < 8; ++c) { const v4u kv = kp[c]; const unsigned w[4] = {kv.x, kv.y, kv.z, kv.w};
#pragma unroll
                    for (int e = 0; e < 4; ++e) {
                        const float q0 = __uint_as_float(__builtin_amdgcn_readlane(__float_as_uint(qv), 8 * c + 2 * e)), q1 = __uint_as_float(__builtin_amdgcn_readlane(__float_as_uint(qv), 8 * c + 2 * e + 1));
                        dot += q0 * __uint_as_float(w[e] << 16) + q1 * __uint_as_float(w[e] & 0xffff0000u); } }
                s[rnd] = valid ? dot + bt[(g * 4 + hh) * 129 + (j <= 128 ? j : 0)] : -INFINITY;
            }
            const float mg = wave_max(fmaxf(fmaxf(s[0], s[1]), s[2]));
            const float mn = fmaxf(m, mg); const float f = __builtin_amdgcn_exp2f(m - mn); acc *= f; l *= f; m = mn;
            float p[3];
#pragma unroll
            for (int rnd = 0; rnd < 3; ++rnd) p[rnd] = __builtin_amdgcn_exp2f(s[rnd] - m);
            l += wave_sum(p[0] + p[1] + p[2]);
            const bf16* vbase = QKV + (size_t)(b * SEQ) * NQKV + 1536 + head * 64 + lane;
#pragma unroll
            for (int rnd = 0; rnd < 3; ++rnd) {
                const int jn = rnd < 2 ? 64 : 1;
                for (int jj = 0; jj < jn; ++jj) { const int j = rnd * 64 + jj; const int pos = t - (j << dsh); if (pos < 0) break;
                    const float pj = __uint_as_float(__builtin_amdgcn_readlane(__float_as_uint(p[rnd]), jj));
                    acc += pj * bf2f(vbase[(size_t)pos * NQKV]); }
            }
        }
        OATT[(size_t)bt_ * AO + hh * 64 + lane] = f2bf16(acc / l);
    }
}

__device__ __forceinline__ float softplus_f(float x) { return x > 20.f ? x : log1pf(expf(x)); }
__device__ __forceinline__ float sigmoid_f(float x) { return 1.0f / (1.0f + expf(-x)); }
__device__ __forceinline__ float red16(float v) { v += __shfl_xor(v, 1); v += __shfl_xor(v, 2); v += __shfl_xor(v, 4); v += __shfl_xor(v, 8); return v; }
__device__ __forceinline__ float red8(float v) { v += __shfl_xor(v, 1); v += __shfl_xor(v, 2); v += __shfl_xor(v, 4); return v; }
__device__ __forceinline__ void rwkv_chain_naive(Frame& F, const Args& A, int chain) {
    const int b = chain >> 4, h = chain & 15, tid = F.tid;
    LAS float* L = (LAS float*)F.lds;
    LAS float* Ww = L; LAS float* Wa = L + 4096; LAS float* Wg = L + 8192;
    LAS float* R = L + 16384; LAS float* K = L + 18432; LAS float* V = L + 20480;
    LAS float* T1 = L + 22528;
    LAS float* Y = L + 30720;
    LAS float* VEC = (LAS float*)(F.lds + VEC_OFF);
    const float* w_w2 = A.in[10]; const float* w_a2 = A.in[12]; const float* w_g2 = A.in[13]; const float* mu = A.in[8];
    const bf16* Fm = (const bf16*)(A.ws + WS_F); bf16* ORW = (bf16*)(A.ws + WS_XN);
    for (int i = tid; i < 4096; i += 512) { Ww[i] = w_w2[(size_t)(i >> 6) * 1024 + h * 64 + (i & 63)]; Wa[i] = w_a2[(size_t)(i >> 6) * 1024 + h * 64 + (i & 63)]; }
    for (int i = tid; i < 8192; i += 512) Wg[i] = w_g2[(size_t)(i >> 6) * 1024 + h * 64 + (i & 63)];
    if (tid < 64) { const int c = h * 64 + tid; VEC[tid] = A.in[9][c]; VEC[64 + tid] = A.in[11][c]; VEC[128 + tid] = A.in[14][c]; VEC[192 + tid] = A.in[15][c];
        VEC[256 + tid] = A.in[16][c]; VEC[320 + tid] = A.in[17][c]; VEC[384 + tid] = A.in[18][c]; }
    __syncthreads();
    float st[8];
#pragma unroll
    for (int j = 0; j < 8; ++j) st[j] = 0.f;
    for (int tb = 0; tb < SEQ / 32; ++tb) {
        for (int idx = tid; idx < 32 * 448; idx += 512) {
            const int tok = idx / 448, col = idx % 448, t = tb * 32 + tok;
            const int gcol = col < 64 ? h * 64 + col : col < 128 ? 1024 + h * 64 + (col - 64) : col < 192 ? 2048 + h * 64 + (col - 128) : 3072 + (col - 192);
            const size_t row = (size_t)(b * SEQ + t);
            const float cur = bf2f(Fm[row * NF + gcol]); const float prev = t > 0 ? bf2f(Fm[(row - 1) * NF + gcol]) : 0.f;
            const float xs = cur + (prev - cur) * mu[gcol];
            if (col < 64) R[tok * 64 + col] = xs; else if (col < 128) K[tok * 64 + col - 64] = xs; else if (col < 192) V[tok * 64 + col - 128] = xs;
            else if (col < 256) T1[tok * 64 + col - 192] = tanhf(xs); else if (col < 320) T1[2048 + tok * 64 + col - 256] = xs; else T1[4096 + tok * 128 + col - 320] = sigmoid_f(xs);
        }
        __syncthreads();
        const int tok = tid >> 4, c0 = (tid & 15) * 4;
        float dw[4] = {0.f, 0.f, 0.f, 0.f}, da[4] = {0.f, 0.f, 0.f, 0.f}, dg[4] = {0.f, 0.f, 0.f, 0.f};
        for (int i = 0; i < 64; ++i) { const float tw = T1[tok * 64 + i], fa = T1[2048 + tok * 64 + i];
#pragma unroll
            for (int e = 0; e < 4; ++e) { dw[e] += tw * Ww[i * 64 + c0 + e]; da[e] += fa * Wa[i * 64 + c0 + e]; } }
        for (int i = 0; i < 128; ++i) { const float sg = T1[4096 + tok * 128 + i];
#pragma unroll
            for (int e = 0; e < 4; ++e) dg[e] += sg * Wg[i * 64 + c0 + e]; }
        __syncthreads();
        { float kkv[4], av[4], kraw[4]; float ss = 0.f;
#pragma unroll
            for (int e = 0; e < 4; ++e) { const int c = c0 + e; const float wraw = VEC[c] + dw[e]; const float wlog = -softplus_f(-wraw) - 0.5f;
                T1[tok * 64 + c] = expf(-expf(wlog));
                av[e] = sigmoid_f(VEC[64 + c] + da[e]); kraw[e] = K[tok * 64 + c]; kkv[e] = kraw[e] * VEC[128 + c]; ss += kkv[e] * kkv[e]; }
            ss = red16(ss); const float nrm = fmaxf(sqrtf(ss), 1e-12f); float bon = 0.f;
#pragma unroll
            for (int e = 0; e < 4; ++e) { const int c = c0 + e; const float kk = kkv[e] / nrm; const float kp = kraw[e] * (1.0f + (av[e] - 1.0f) * VEC[192 + c]);
                T1[2048 + tok * 64 + c] = kk; T1[4096 + tok * 64 + c] = kk * av[e]; T1[6144 + tok * 64 + c] = dg[e]; K[tok * 64 + c] = kp;
                bon += R[tok * 64 + c] * kp * VEC[256 + c]; }
            bon = red16(bon); if ((tid & 15) == 0) VEC[448 + tok] = bon; }
        __syncthreads();
        { const int i = tid >> 3, j0 = (tid & 7) * 8;
            for (int s = 0; s < 32; ++s) {
                float kk[8], dc[8], bb[8], kp[8], rr[8];
#pragma unroll
                for (int j = 0; j < 8; ++j) { kk[j] = T1[2048 + s * 64 + j0 + j]; dc[j] = T1[s * 64 + j0 + j]; bb[j] = T1[4096 + s * 64 + j0 + j]; kp[j] = K[s * 64 + j0 + j]; rr[j] = R[s * 64 + j0 + j]; }
                const float vi = V[s * 64 + i];
                float sa = 0.f;
#pragma unroll
                for (int j = 0; j < 8; ++j) sa += st[j] * kk[j];
                sa = -red8(sa);
                float y = 0.f;
#pragma unroll
                for (int j = 0; j < 8; ++j) { st[j] = st[j] * dc[j] + sa * bb[j] + vi * kp[j]; y += st[j] * rr[j]; }
                y = red8(y);
                if ((tid & 7) == 0) Y[s * 64 + i] = y;
            } }
        __syncthreads();
        { float yv[4]; float sm = 0.f;
#pragma unroll
            for (int e = 0; e < 4; ++e) { yv[e] = Y[tok * 64 + c0 + e]; sm += yv[e]; }
            const float mean = red16(sm) * (1.f / 64.f); float sq = 0.f;
#pragma unroll
            for (int e = 0; e < 4; ++e) { yv[e] -= mean; sq += yv[e] * yv[e]; }
            const float rstd = 1.0f / sqrtf(red16(sq) * (1.f / 64.f) + LNX_EPS); const float bon = VEC[448 + tok];
            const size_t row = (size_t)(b * SEQ + tb * 32 + tok); unsigned short o[4];
#pragma unroll
            for (int e = 0; e < 4; ++e) { const int c = c0 + e; o[e] = f2bf16((yv[e] * rstd * VEC[320 + c] + VEC[384 + c] + bon * V[tok * 64 + c]) * T1[6144 + tok * 64 + c]); }
            *(unsigned long long*)(ORW + row * D + h * 64 + c0) = (unsigned long long)o[0] | ((unsigned long long)o[1] << 16) | ((unsigned long long)o[2] << 32) | ((unsigned long long)o[3] << 48); }
        __syncthreads();
    }
}

__device__ __forceinline__ void row_norm_res(int lane, const float* xrow, const float* zrow, const float* g1, float* orow, const float* g2, bf16* hrow) {
    const GAS f32x4* xr = (const GAS f32x4*)xrow + lane; const GAS f32x4* zr = (const GAS f32x4*)zrow + lane; const GAS f32x4* g1r = (const GAS f32x4*)g1 + lane;
    f32x4 z[4], x[4]; float s = 0.f;
#pragma unroll
    for (int j = 0; j < 4; ++j) { z[j] = zr[64 * j]; x[j] = xr[64 * j]; s += (z[j].x * z[j].x + z[j].y * z[j].y) + (z[j].z * z[j].z + z[j].w * z[j].w); }
    const float rs = 1.0f / sqrtf(wave_sum(s) * (1.f / D) + NORM_EPS); float s2 = 0.f;
#pragma unroll
    for (int j = 0; j < 4; ++j) { const f32x4 gg = g1r[64 * j]; x[j] = x[j] + z[j] * rs * gg; s2 += (x[j].x * x[j].x + x[j].y * x[j].y) + (x[j].z * x[j].z + x[j].w * x[j].w); }
    GAS f32x4* o = (GAS f32x4*)orow + lane;
#pragma unroll
    for (int j = 0; j < 4; ++j) o[64 * j] = x[j];
    if (hrow) { const float rs2 = 1.0f / sqrtf(wave_sum(s2) * (1.f / D) + NORM_EPS); const GAS f32x4* g2r = (const GAS f32x4*)g2 + lane;
        GAS unsigned long long* o8 = (GAS unsigned long long*)hrow + lane;
#pragma unroll
        for (int j = 0; j < 4; ++j) { const f32x4 gg = g2r[64 * j];
            o8[64 * j] = (unsigned long long)pk2(x[j].x * rs2 * gg.x, x[j].y * rs2 * gg.y) | ((unsigned long long)pk2(x[j].z * rs2 * gg.z, x[j].w * rs2 * gg.w) << 32); } }
}

__global__ void __launch_bounds__(NWAVES * 64, 2) fwd_kernel(Args args) {
    extern __shared__ __attribute__((aligned(16))) unsigned char lds[];
    Frame F;
    F.lds = (LAS unsigned char*)lds;
    F.MISC = (volatile LAS unsigned*)(F.lds + MISC_OFF);
    F.tid = threadIdx.x; F.lane = F.tid & 63; F.wave = __builtin_amdgcn_readfirstlane(F.tid >> 6);
    F.G = gridDim.x; { const int bx = blockIdx.x; F.vcu = (F.G % 8 == 0) ? (bx % 8) * (F.G / 8) + bx / 8 : bx; }
    const Args& A = args;
    F.ctl = (gu32*)(args.ws + WS_CTL);
    for (int u = F.tid; u < (LDS_BYTES - LDSCTL_OFF) / 4; u += NWAVES * 64) ((LAS unsigned*)(F.lds + LDSCTL_OFF))[u] = 0u;
    __syncthreads();
    XcdBarrier bar = xcd_barrier_post((unsigned*)(F.ctl + CW_BAR), F.MISC + 8);
#define GRID_BAR() xcd_barrier(bar)
    unsigned char* ws = args.ws;
    bf16* XN = (bf16*)(ws + WS_XN); bf16* QKV = (bf16*)(ws + WS_QKV); bf16* FB = (bf16*)(ws + WS_F); bf16* GATE = (bf16*)args.out; bf16* OATT = (bf16*)(ws + WS_OATT);
    float* TMP = (float*)(ws + WS_TMP); bf16* MERGED = (bf16*)(ws + WS_MERGED); float* Z = (float*)(ws + WS_Z); bf16* HB = (bf16*)(ws + WS_H); float* Z2 = (float*)(ws + WS_Z2);

    p0_prologue(F, A);
    GRID_BAR();
    { pg8::Gemm g{XN, (const bf16*)(ws + WS_WIN), M, NIN, D}; pg8::StaticOrder S; S.init(M, NIN, F.G, (int)blockIdx.x);
      pg8::EpiProj E{QKV, FB, GATE, A.in[7], QSCALE};
      pg8::gemm_phase<pg8::EpiProj, pg8::StaticOrder, true, true>(F.lds + RING_OFF, g, S, E); }
    GRID_BAR();
    { const int nR = F.G >= 2 ? (F.G / 2 < 128 ? F.G / 2 : 128) : 0;
      if ((int)blockIdx.x < nR) { for (int c = blockIdx.x; c < BATCH * 16; c += nR) rwkv_chain_naive(F, A, c); }
      else { const int nA = F.G - nR; attn_naive(F, A, ((int)blockIdx.x - nR) * NWAVES + F.wave, nA * NWAVES); } }
    GRID_BAR();
    { int kao = AO; asm volatile("" : "+s"(kao));
      pg8::Gemm g{OATT, (const bf16*)(ws + WS_WA), M, D, kao}; pg8::StaticOrder S; S.init(M, D, F.G, (int)blockIdx.x);
      pg8::EpiGateF32 E{TMP, GATE, 0};
      pg8::gemm_phase<pg8::EpiGateF32, pg8::StaticOrder, true, true>(F.lds + RING_OFF, g, S, E); }
    GRID_BAR();
    { pg8::Gemm g{XN  , (const bf16*)(ws + WS_WR), M, D, D}; pg8::StaticOrder S; S.init(M, D, F.G, (int)blockIdx.x);
      pg8::EpiMerge E{MERGED, TMP, GATE, 1024};
      pg8::gemm_phase<pg8::EpiMerge, pg8::StaticOrder, true, true>(F.lds + RING_OFF, g, S, E); }
    GRID_BAR();
    { pg8::Gemm g{MERGED, (const bf16*)(ws + WS_WO), M, D, D}; pg8::StaticOrder S; S.init(M, D, F.G, (int)blockIdx.x);
      pg8::EpiF32 E{Z, D};
      pg8::gemm_phase<pg8::EpiF32, pg8::StaticOrder, true, true>(F.lds + RING_OFF, g, S, E); }
    GRID_BAR();
    { const int gw = F.vcu * NWAVES + F.wave, NGW = F.G * NWAVES;
      for (int m = gw; m < M; m += NGW) row_norm_res(F.lane, A.in[0] + (size_t)m * D, Z + (size_t)m * D, A.in[3], A.out + (size_t)m * D, A.in[4], XN + (size_t)m * D); }
    GRID_BAR();
    { pg8::Gemm g{XN, (const bf16*)(ws + WS_W1), M, FF, D}; pg8::StaticOrder S; S.init(M, FF, F.G, (int)blockIdx.x);
      pg8::EpiRelu2 E{HB, FF};
      pg8::gemm_phase<pg8::EpiRelu2, pg8::StaticOrder, true, true>(F.lds + RING_OFF, g, S, E); }
    GRID_BAR();
    { pg8::Gemm g{HB, (const bf16*)(ws + WS_W2), M, D, FF}; pg8::StaticOrder S; S.init(M, D, F.G, (int)blockIdx.x);
      pg8::EpiF32 E{Z2, D};
      pg8::gemm_phase<pg8::EpiF32, pg8::StaticOrder, true, true>(F.lds + RING_OFF, g, S, E); }
    GRID_BAR();
    { const int gw = F.vcu * NWAVES + F.wave, NGW = F.G * NWAVES;
      for (int m = gw; m < M; m += NGW) row_norm_res(F.lane, A.out + (size_t)m * D, Z2 + (size_t)m * D, A.in[5], A.out + (size_t)m * D, nullptr, nullptr); }
}

extern "C" void kernel_launch(void* const* d_in, const int* in_sizes, int n_in, void* d_out, int out_size, void* d_ws, size_t ws_size, hipStream_t stream) {
    static int grid = 0;
    if (grid == 0) {
        if (n_in != NIN_T || out_size != M * D || ws_size < WS_END) { fprintf(stderr, "kernel_launch: unexpected shapes: n_in %d out %d ws %zu\n", n_in, out_size, ws_size); grid = -1; return; }
        int dev = 0, cus = 0, per_cu = 0;
        if (hipGetDevice(&dev) != hipSuccess || hipDeviceGetAttribute(&cus, hipDeviceAttributeMultiprocessorCount, dev) != hipSuccess) { grid = -1; return; }
        if (hipFuncSetAttribute((const void*)fwd_kernel, hipFuncAttributeMaxDynamicSharedMemorySize, LDS_BYTES) != hipSuccess) { fprintf(stderr, "kernel_launch: hipFuncSetAttribute failed\n"); grid = -1; return; }
        if (hipOccupancyMaxActiveBlocksPerMultiprocessor(&per_cu, (const void*)fwd_kernel, NWAVES * 64, LDS_BYTES) != hipSuccess || per_cu < 1) { fprintf(stderr, "kernel_launch: occupancy query says %d\n", per_cu); }
        (void)hipGetLastError();
        grid = cus;
    }
    if (grid < 0) return;
    if (hipMemsetAsync((char*)d_ws + WS_CTL, 0, CTL_ZERO_BYTES, stream) != hipSuccess) { fprintf(stderr, "kernel_launch: memset failed\n"); return; }
    Args a{};
    for (int i = 0; i < NIN_T; ++i) a.in[i] = (const float*)d_in[i];
    a.out = (float*)d_out; a.ws = (unsigned char*)d_ws;
    hipLaunchKernelGGL(fwd_kernel, dim3(grid), dim3(NWAVES * 64), LDS_BYTES, stream, a);
}
```

```cpp
#include <hip/hip_runtime.h>
#include <cstdio>
#include <cstdint>
#include <cmath>
__device__ __forceinline__ int lane_fresh() { int l; asm volatile("v_mbcnt_lo_u32_b32 %0, -1, 0\n\tv_mbcnt_hi_u32_b32 %0, -1, %0" : "=v"(l)); return l; }
namespace pg8 {
#define PG8_LAS __attribute__((address_space(3)))
typedef unsigned short bf16_t;
typedef short bf16x8 __attribute__((ext_vector_type(8)));
typedef float f32x4 __attribute__((ext_vector_type(4)));
typedef unsigned u32x4 __attribute__((ext_vector_type(4)));
constexpr int BM = 256, BK = 64, HALF = 128, HTB = HALF * BK * 2  , STAGE_BYTES = 8 * HTB, NXCD = 8, WGM = 8;

__host__ __device__ __forceinline__ int lds_byte(int r, int c) { const int st = (r >> 4) * 2 + (c >> 5), rr = r & 15, cc = c & 31, ob = rr * 64 + cc * 2; return st * 1024 + (ob ^ (((ob >> 9) & 1) << 5)); }
__host__ __device__ __forceinline__ void stage_rc(int b, int& R, int& C) { const int st = b / 1024, sb = b % 1024, swz = sb ^ (((sb >> 9) & 1) << 5); R = (st >> 1) * 16 + swz / 64; C = (st & 1) * 32 + (swz % 64) / 2; }
__host__ __device__ __forceinline__ int perm32(int rho) { const int n = rho >> 4, i = rho & 15; return 8 * (i >> 2) + 4 * n + (i & 3); }

struct Unit { int pm, pn; };
struct Gemm { const bf16_t* A; const bf16_t* Bt; int M, N, K; int rot = 0; };

struct StaticOrder {
    int nM, nN, nwg, G, c;
    __host__ __device__ void init(int M, int N, int G_, int c_) { nM = M / BM; nN = N / BM; nwg = nM * nN; G = G_; c = c_; }
    __host__ __device__ bool next(int i, Unit& u) const {
        const long L = (long)i * G + c; if (L >= nwg) return false;
        int wgid = (int)L; { const int q = nwg / NXCD, r = nwg % NXCD, xcd = wgid % NXCD, off = wgid / NXCD; wgid = (xcd < r ? xcd * (q + 1) : r * (q + 1) + (xcd - r) * q) + off; }
        const int nig = WGM * nN, gid = wgid / nig, fm = gid * WGM, gsz = (nM - fm) < WGM ? (nM - fm) : WGM;
        u.pm = fm + ((wgid % nig) % gsz); u.pn = (wgid % nig) / gsz; return true;
    }
    __device__ __forceinline__ void a_ready(const Unit&) const {}
    __device__ __forceinline__ void done(const Unit&) const {}
};

__device__ __forceinline__ unsigned cvt_pk_bf16(float lo, float hi) { unsigned r; asm volatile("v_cvt_pk_bf16_f32 %0, %1, %2" : "=v"(r) : "v"(lo), "v"(hi)); return r; }
typedef float f32x2 __attribute__((ext_vector_type(2)));
__device__ __forceinline__ float bf2f(unsigned short b) { return __uint_as_float(((unsigned)b) << 16); }
__device__ __forceinline__ float sigm_fast(float x) { return __builtin_amdgcn_rcpf(1.0f + __builtin_amdgcn_exp2f(-1.4426950408889634f * x)); }
__device__ __forceinline__ f32x4 unpack_lo4(unsigned a, unsigned b) { return (f32x4){__uint_as_float(a << 16), __uint_as_float(a & 0xffff0000u), __uint_as_float(b << 16), __uint_as_float(b & 0xffff0000u)}; }

struct EpiProj {
    static constexpr bool PERM = true, AFTER_DRAIN = false; static constexpr int MIDK = 0;
    bf16_t* QKV; bf16_t* F; bf16_t* GATE; const float* b_gate; float qscale;
    __device__ __forceinline__ void operator()(const f32x4 (&acc)[2][2][4][2], const Unit& u, int wr, int wc, int fr, int fq) const {
        const int row0 = u.pm * BM + wr * 64 + fr; const int pn = u.pn;
        bf16_t* base; int ldc, colt, mode;
        if (pn < 9) { base = QKV; ldc = 2304; colt = pn * 256; mode = pn < 3 ? 1 : 0; }
        else if (pn < 22) { base = F; ldc = 3328; colt = (pn - 9) * 256; mode = 0; }
        else { base = GATE; ldc = 2048; colt = (pn - 22) * 256; mode = 2; }
        const int col0 = colt + wc * 32 + 8 * fq;
        const float sc = (mode == 1) ? qscale : 1.0f;
#pragma unroll
        for (int ai = 0; ai < 2; ++ai)
#pragma unroll
            for (int m = 0; m < 4; ++m) { bf16_t* rowp = base + (size_t)(row0 + ai * HALF + m * 16) * ldc + col0;
#pragma unroll
                for (int bj = 0; bj < 2; ++bj) { f32x4 v0 = acc[ai][bj][m][0] * sc, v1 = acc[ai][bj][m][1] * sc;
                    if (mode == 2) { v0 += *(const f32x4*)(b_gate + col0 + bj * HALF); v1 += *(const f32x4*)(b_gate + col0 + bj * HALF + 4); v0 = (f32x4){sigm_fast(v0[0]), sigm_fast(v0[1]), sigm_fast(v0[2]), sigm_fast(v0[3])}; v1 = (f32x4){sigm_fast(v1[0]), sigm_fast(v1[1]), sigm_fast(v1[2]), sigm_fast(v1[3])}; }
                    u32x4 w; w.x = cvt_pk_bf16(v0[0], v0[1]); w.y = cvt_pk_bf16(v0[2], v0[3]); w.z = cvt_pk_bf16(v1[0], v1[1]); w.w = cvt_pk_bf16(v1[2], v1[3]);
                    __builtin_nontemporal_store(w, (u32x4*)(rowp + bj * HALF)); }
                asm volatile("" ::: "memory"); }
    }
};
struct EpiMerge2 {
    static constexpr bool PERM = true, AFTER_DRAIN = false; static constexpr int MIDK = 4;
    bf16_t* OUT; const bf16_t* GN; const bf16_t* GD; int midk;
    __device__ __forceinline__ void mid(f32x4 (&acc)[2][2][4][2], const Unit& u, int wr, int wc, int fr, int fq) const {
        int fr_ = fr, fq_ = fq; asm volatile("" : "+v"(fr_), "+v"(fq_));
        const int row0 = u.pm * BM + wr * 64 + fr_, col0 = u.pn * BM + wc * 32 + 8 * fq_;
#pragma unroll
        for (int ai = 0; ai < 2; ++ai)
#pragma unroll
            for (int m = 0; m < 4; ++m) { const size_t r = (size_t)(row0 + ai * HALF + m * 16);
#pragma unroll
                for (int bj = 0; bj < 2; ++bj) { const int c = col0 + bj * HALF;
                    const u32x4 g0 = *(const u32x4*)(GN + r * 2048 + c), g1 = *(const u32x4*)(GD + r * 2048 + c);
                    const f32x4 a0 = unpack_lo4(g0.x, g0.y), a1 = unpack_lo4(g0.z, g0.w), b0 = unpack_lo4(g1.x, g1.y), b1 = unpack_lo4(g1.z, g1.w);
#pragma unroll
                    for (int e = 0; e < 4; ++e) { acc[ai][bj][m][0][e] *= a0[e] * __builtin_amdgcn_rcpf(fmaxf(b0[e], 1e-8f)); acc[ai][bj][m][1][e] *= a1[e] * __builtin_amdgcn_rcpf(fmaxf(b1[e], 1e-8f)); } }
                asm volatile("" ::: "memory"); }
    }
    __device__ __forceinline__ void operator()(const f32x4 (&acc)[2][2][4][2], const Unit& u, int wr, int wc, int fr, int fq) const {
        int fr_ = fr, fq_ = fq; asm volatile("" : "+v"(fr_), "+v"(fq_));
        const int row0 = u.pm * BM + wr * 64 + fr_, col0 = u.pn * BM + wc * 32 + 8 * fq_;
#pragma unroll
        for (int ai = 0; ai < 2; ++ai)
#pragma unroll
            for (int m = 0; m < 4; ++m) { const size_t r = (size_t)(row0 + ai * HALF + m * 16);
#pragma unroll
                for (int bj = 0; bj < 2; ++bj) { const int c = col0 + bj * HALF;
                    const u32x4 g = *(const u32x4*)(GD + r * 2048 + c);
                    const f32x4 v0 = acc[ai][bj][m][0] * unpack_lo4(g.x, g.y), v1 = acc[ai][bj][m][1] * unpack_lo4(g.z, g.w);
                    u32x4 w; w.x = cvt_pk_bf16(v0[0], v0[1]); w.y = cvt_pk_bf16(v0[2], v0[3]); w.z = cvt_pk_bf16(v1[0], v1[1]); w.w = cvt_pk_bf16(v1[2], v1[3]);
                    *(u32x4*)(OUT + r * 1024 + c) = w; }
                asm volatile("" ::: "memory"); }
    }
};
struct EpiRelu2 {
    static constexpr bool PERM = true, AFTER_DRAIN = false; static constexpr int MIDK = 0;
    bf16_t* O; int ldc;
    __device__ __forceinline__ void operator()(const f32x4 (&acc)[2][2][4][2], const Unit& u, int wr, int wc, int fr, int fq) const {
        const int row0 = u.pm * BM + wr * 64 + fr, col0 = u.pn * BM + wc * 32 + 8 * fq;
#pragma unroll
        for (int ai = 0; ai < 2; ++ai)
#pragma unroll
            for (int m = 0; m < 4; ++m) { bf16_t* rowp = O + (size_t)(row0 + ai * HALF + m * 16) * ldc + col0;
#pragma unroll
                for (int bj = 0; bj < 2; ++bj) { f32x4 v0 = acc[ai][bj][m][0], v1 = acc[ai][bj][m][1];
#pragma unroll
                    for (int e = 0; e < 4; ++e) { const float a = fmaxf(v0[e], 0.f), b = fmaxf(v1[e], 0.f); v0[e] = a * a; v1[e] = b * b; }
                    u32x4 w; w.x = cvt_pk_bf16(v0[0], v0[1]); w.y = cvt_pk_bf16(v0[2], v0[3]); w.z = cvt_pk_bf16(v1[0], v1[1]); w.w = cvt_pk_bf16(v1[2], v1[3]);
                    __builtin_nontemporal_store(w, (u32x4*)(rowp + bj * HALF)); } }
    }
};
struct EpiBf16Plain {
    static constexpr bool PERM = true, AFTER_DRAIN = false; static constexpr int MIDK = 0;
    bf16_t* O; int ldc;
    __device__ __forceinline__ void operator()(const f32x4 (&acc)[2][2][4][2], const Unit& u, int wr, int wc, int fr, int fq) const {
        const int row0 = u.pm * BM + wr * 64 + fr, col0 = u.pn * BM + wc * 32 + 8 * fq;
#pragma unroll
        for (int ai = 0; ai < 2; ++ai)
#pragma unroll
            for (int m = 0; m < 4; ++m) { bf16_t* rowp = O + (size_t)(row0 + ai * HALF + m * 16) * ldc + col0;
#pragma unroll
                for (int bj = 0; bj < 2; ++bj) { const f32x4 v0 = acc[ai][bj][m][0], v1 = acc[ai][bj][m][1];
                    u32x4 w; w.x = cvt_pk_bf16(v0[0], v0[1]); w.y = cvt_pk_bf16(v0[2], v0[3]); w.z = cvt_pk_bf16(v1[0], v1[1]); w.w = cvt_pk_bf16(v1[2], v1[3]);
                    __builtin_nontemporal_store(w, (u32x4*)(rowp + bj * HALF)); } }
    }
};
template <class Epi, class Sched, bool ALIGN_EPI = false, bool SP2 = false>
__device__ __forceinline__ void gemm_phase(PG8_LAS unsigned char* lds, const Gemm g, const Sched& S, const Epi& E, int wave_) {
    const int lane = lane_fresh(), wid = wave_, tid = (wave_ << 6) | lane, wr = wid >> 2, wc = wid & 3, fr = lane & 15, fq = lane >> 4;
    const int K = g.K, nt = K / BK, rot = (Epi::MIDK > 0) ? g.rot : 0;
    unsigned voffA[2], voffB[2];
#pragma unroll
    for (int i = 0; i < 2; ++i) { int R, C; stage_rc(tid * 16 + i * 8192, R, C); const int Rb = Epi::PERM ? ((R & ~31) + perm32(R & 31)) : R;
        voffA[i] = (unsigned)(R * K + C) * 2u; voffB[i] = (unsigned)(Rb * K + C) * 2u; }
    const size_t kstep = (size_t)(BK * 2);
#define PG8_KOFF(t_) ((size_t)(((t_) + rot) >= nt ? ((t_) + rot - nt) : ((t_) + rot)) * kstep)
    const size_t hstep = (size_t)HALF * K * 2;
    const size_t tstep = 2 * hstep;
    const unsigned ldsw = (unsigned)wid * 1024u;
    const int aoff = lds_byte(wr * 64 + fr, fq * 8), boff = lds_byte(wc * 32 + fr, fq * 8);
#define PG8_SA(b, h) (((b) * 2 + (h)) * HTB)
#define PG8_SB(b, h) ((4 + (b) * 2 + (h)) * HTB)
#define PG8_STAGE(bufoff, gbase, voff) do { _Pragma("unroll") for (int _i = 0; _i < 2; ++_i) \
        __builtin_amdgcn_global_load_lds((const unsigned*)((const char*)(gbase) + (voff)[_i]), (PG8_LAS unsigned*)(lds + (bufoff) + ldsw + _i * 8192), 16, 0, 0); } while (0)
#define PG8_LDA(dst, b, h) do { _Pragma("unroll") for (int m = 0; m < 4; ++m) _Pragma("unroll") for (int k = 0; k < 2; ++k) dst[m][k] = *(const PG8_LAS bf16x8*)(lds + PG8_SA(b, h) + aoff + m * 2048 + k * 1024); } while (0)
#define PG8_LDB(dst, b, h) do { _Pragma("unroll") for (int n = 0; n < 2; ++n) _Pragma("unroll") for (int k = 0; k < 2; ++k) dst[n][k] = *(const PG8_LAS bf16x8*)(lds + PG8_SB(b, h) + boff + n * 2048 + k * 1024); } while (0)
#define PG8_MMA(ai, bj, At, Bt) do { __builtin_amdgcn_s_setprio(1); _Pragma("unroll") for (int m = 0; m < 4; ++m) _Pragma("unroll") for (int n = 0; n < 2; ++n) _Pragma("unroll") for (int k = 0; k < 2; ++k) \
        acc[ai][bj][m][n] = __builtin_amdgcn_mfma_f32_16x16x32_bf16(Bt[n][k], At[m][k], acc[ai][bj][m][n], 0, 0, 0); __builtin_amdgcn_s_setprio(0); } while (0)
#define PG8_WAIT_V(n) asm volatile("s_waitcnt vmcnt(" #n ")" ::: "memory")
#define PG8_WAIT_L(n) asm volatile("s_waitcnt lgkmcnt(" #n ")" ::: "memory")
#define PG8_BAR __builtin_amdgcn_s_barrier()
#define PG8_SCHED __builtin_amdgcn_sched_barrier(0)
    Unit cur, nxt; int ui = 0;
    if (!S.next(0, cur)) return;
    f32x4 acc[2][2][4][2];
#pragma unroll
    for (int a = 0; a < 2; ++a)
#pragma unroll
        for (int b = 0; b < 2; ++b)
#pragma unroll
            for (int m = 0; m < 4; ++m)
#pragma unroll
                for (int n = 0; n < 2; ++n) acc[a][b][m][n] = (f32x4){0.f, 0.f, 0.f, 0.f};
    bf16x8 At[4][2], B0[2][2], B1[2][2];
    const char* cA = (const char*)g.A + (size_t)cur.pm * tstep; const char* cB = (const char*)g.Bt + (size_t)cur.pn * tstep;
    S.a_ready(cur);
    if constexpr (SP2) {
        PG8_STAGE(PG8_SB(0, 0), cB + PG8_KOFF(0), voffB); PG8_STAGE(PG8_SB(0, 1), cB + PG8_KOFF(0) + hstep, voffB); PG8_STAGE(PG8_SA(0, 0), cA + PG8_KOFF(0), voffA); PG8_STAGE(PG8_SA(0, 1), cA + PG8_KOFF(0) + hstep, voffA);
        if (wr == 1) PG8_BAR;
        PG8_WAIT_V(2); PG8_BAR;
        PG8_STAGE(PG8_SB(1, 0), cB + PG8_KOFF(1), voffB); PG8_STAGE(PG8_SA(1, 0), cA + PG8_KOFF(1), voffA); PG8_STAGE(PG8_SB(1, 1), cB + hstep + PG8_KOFF(1), voffB);
        PG8_WAIT_V(6); PG8_BAR;
    } else {
        PG8_STAGE(PG8_SB(0, 0), cB + PG8_KOFF(0), voffB); PG8_STAGE(PG8_SA(0, 0), cA + PG8_KOFF(0), voffA); PG8_STAGE(PG8_SB(0, 1), cB + PG8_KOFF(0) + hstep, voffB); PG8_STAGE(PG8_SA(0, 1), cA + PG8_KOFF(0) + hstep, voffA);
        if (wr == 1) PG8_BAR;
        PG8_WAIT_V(4); PG8_BAR;
        PG8_STAGE(PG8_SB(1, 0), cB + PG8_KOFF(1), voffB); PG8_STAGE(PG8_SA(1, 0), cA + PG8_KOFF(1), voffA); PG8_STAGE(PG8_SB(1, 1), cB + hstep + PG8_KOFF(1), voffB);
        PG8_WAIT_V(6); PG8_BAR;
    }
    for (;;) {
        const bool has_next = S.next(ui + 1, nxt);
        const char* nA = has_next ? (const char*)g.A + (size_t)nxt.pm * tstep : cA; const char* nB = has_next ? (const char*)g.Bt + (size_t)nxt.pn * tstep : cB;
        for (int t = 0; t < nt; t += 2) {
            if constexpr (Epi::MIDK > 0) { if (t == E.midk) E.mid(acc, cur, wr, wc, fr, fq); }
            const bool last = (t == nt - 2);
            const char* a1 = cA + PG8_KOFF(t + 1);
            const size_t o2 = last ? PG8_KOFF(0) : PG8_KOFF(t + 2), o3 = last ? PG8_KOFF(1) : PG8_KOFF(t + 3);
            const char* a2 = (last ? nA : cA) + o2; const char* b2 = (last ? nB : cB) + o2;
            const char* a3 = (last ? nA : cA) + o3; const char* b3 = (last ? nB : cB) + o3;
            if (last && has_next) S.a_ready(nxt);
            if constexpr (SP2) {
            PG8_LDB(B0, 0, 0); PG8_LDB(B1, 0, 1); PG8_SCHED; PG8_LDA(At, 0, 0); PG8_STAGE(PG8_SA(1, 1), a1 + hstep, voffA);
            PG8_WAIT_V(8); PG8_WAIT_L(0); PG8_BAR; PG8_MMA(0, 0, At, B0); PG8_MMA(0, 1, At, B1); PG8_BAR; PG8_SCHED;
            PG8_LDA(At, 0, 1); PG8_STAGE(PG8_SB(0, 0), b2, voffB); PG8_STAGE(PG8_SB(0, 1), b2 + hstep, voffB); PG8_STAGE(PG8_SA(0, 0), a2, voffA);
            PG8_WAIT_V(8); PG8_WAIT_L(0); PG8_BAR; PG8_MMA(1, 0, At, B0); PG8_MMA(1, 1, At, B1); PG8_BAR; PG8_SCHED;
            PG8_LDB(B0, 1, 0); PG8_LDB(B1, 1, 1); PG8_SCHED; PG8_LDA(At, 1, 0); PG8_STAGE(PG8_SA(0, 1), a2 + hstep, voffA);
            PG8_WAIT_V(8); PG8_WAIT_L(0); PG8_BAR; PG8_MMA(0, 0, At, B0); PG8_MMA(0, 1, At, B1); PG8_BAR; PG8_SCHED;
            PG8_LDA(At, 1, 1); PG8_STAGE(PG8_SB(1, 0), b3, voffB); PG8_STAGE(PG8_SB(1, 1), b3 + hstep, voffB); PG8_STAGE(PG8_SA(1, 0), a3, voffA);
            PG8_WAIT_V(8); PG8_WAIT_L(0); PG8_BAR; PG8_MMA(1, 0, At, B0); PG8_MMA(1, 1, At, B1); PG8_BAR; PG8_SCHED;
            } else {
            PG8_LDB(B0, 0, 0); PG8_SCHED; PG8_LDA(At, 0, 0); PG8_STAGE(PG8_SA(1, 1), a1 + hstep, voffA);
            PG8_WAIT_L(8); PG8_BAR; PG8_WAIT_L(0); PG8_MMA(0, 0, At, B0); PG8_BAR; PG8_SCHED;
            PG8_LDB(B1, 0, 1); PG8_STAGE(PG8_SB(0, 0), b2, voffB);
            PG8_BAR; PG8_WAIT_L(0); PG8_MMA(0, 1, At, B1); PG8_BAR;
            PG8_LDA(At, 0, 1); PG8_STAGE(PG8_SA(0, 0), a2, voffA);
            PG8_BAR; PG8_WAIT_L(0); PG8_MMA(1, 0, At, B0); PG8_BAR; PG8_SCHED;
            PG8_STAGE(PG8_SB(0, 1), b2 + hstep, voffB);
            PG8_WAIT_V(6); PG8_BAR; PG8_MMA(1, 1, At, B1); PG8_BAR;
            PG8_LDB(B0, 1, 0); PG8_SCHED; PG8_LDA(At, 1, 0); PG8_STAGE(PG8_SA(0, 1), a2 + hstep, voffA);
            PG8_WAIT_L(8); PG8_BAR; PG8_WAIT_L(0); PG8_MMA(0, 0, At, B0); PG8_BAR; PG8_SCHED;
            PG8_LDB(B1, 1, 1); PG8_STAGE(PG8_SB(1, 0), b3, voffB);
            PG8_BAR; PG8_WAIT_L(0); PG8_MMA(0, 1, At, B1); PG8_BAR;
            PG8_LDA(At, 1, 1); PG8_STAGE(PG8_SA(1, 0), a3, voffA);
            PG8_BAR; PG8_WAIT_L(0); PG8_MMA(1, 0, At, B0); PG8_BAR; PG8_SCHED;
            PG8_STAGE(PG8_SB(1, 1), b3 + hstep, voffB);
            PG8_WAIT_V(6); PG8_BAR; PG8_MMA(1, 1, At, B1); PG8_BAR;
            }
        }
        if constexpr (ALIGN_EPI) { if (wr == 0) PG8_BAR; }
        if constexpr (!Epi::AFTER_DRAIN) { E(acc, cur, wr, wc, fr, fq); S.done(cur); }
        if (!has_next) break;
#pragma unroll
        for (int a = 0; a < 2; ++a)
#pragma unroll
            for (int b = 0; b < 2; ++b)
#pragma unroll
                for (int m = 0; m < 4; ++m)
#pragma unroll
                    for (int n = 0; n < 2; ++n) acc[a][b][m][n] = (f32x4){0.f, 0.f, 0.f, 0.f};
        cur = nxt; cA = nA; cB = nB; ++ui;
        if constexpr (ALIGN_EPI) { if (wr == 1) PG8_BAR; }
    }
    PG8_WAIT_V(0);
    if constexpr (!ALIGN_EPI) { if (wr == 0) PG8_BAR; }
    PG8_BAR;
    if constexpr (Epi::AFTER_DRAIN) { E.fused(acc, cur, wr, wc, fr, fq, lds, wid, lane); S.done(cur); }
#undef PG8_SA
#undef PG8_SB
#undef PG8_STAGE
#undef PG8_LDA
#undef PG8_LDB
#undef PG8_MMA
#undef PG8_WAIT_V
#undef PG8_WAIT_L
#undef PG8_BAR
#undef PG8_SCHED
#undef PG8_KOFF
}
}
constexpr int NWAVES = 8;
constexpr int BATCH = 8, SEQ = 4096, D = 1024, M = BATCH * SEQ;
constexpr int NQKV = 2304, NF = 3328, NG = 2048, NIN = 7680, FF = 4096, AO = 256;
constexpr float NORM_EPS = 1e-6f, LNX_EPS = 64e-5f, LOG2E = 1.4426950408889634f;
constexpr float QSCALE = 0.125f * LOG2E;
constexpr int NIN_T = 24;
constexpr size_t KiB = 1024, MiB = 1u << 20;
constexpr size_t WS_CTL = 0, CTL_ZERO_BYTES = 1 * MiB;
constexpr size_t WS_SMALL = 1 * MiB;
constexpr size_t WS_LORA = 1 * MiB + 64 * KiB;
constexpr size_t WS_WCAT = 2 * MiB;
constexpr size_t WS_WO = 4 * MiB + 512 * KiB;
constexpr size_t WS_W1 = 6 * MiB + 512 * KiB;
constexpr size_t WS_W2 = 14 * MiB + 512 * KiB;
constexpr size_t WS_WIN = 24 * MiB;
constexpr size_t WS_ACAT = 24 * MiB;
constexpr size_t WS_XS = 104 * MiB;
constexpr size_t WS_XN = 40 * MiB;
constexpr size_t WS_QKV = 104 * MiB;
constexpr size_t WS_F = 248 * MiB;
constexpr size_t WS_OPART = 456 * MiB;
constexpr size_t WS_LSE = 504 * MiB;
constexpr size_t WS_MERGED = WS_F;
constexpr size_t WS_Z = 424 * MiB;
constexpr size_t WS_H = 104 * MiB;
constexpr size_t WS_Z2 = 360 * MiB;
constexpr size_t WS_END = 512 * MiB;
static_assert(WS_Z + (size_t)M * D * 2 <= WS_END && WS_H + (size_t)M * FF * 2 <= WS_Z2 && WS_Z2 + (size_t)M * D * 2 <= WS_Z && WS_LSE + (size_t)3 * M * 4 * 4 <= WS_END
              && WS_W2 + (size_t)D * FF * 2 <= WS_WIN && WS_WIN + (size_t)NIN * D * 2 <= WS_XN && WS_ACAT + (size_t)M * 1280 * 2 <= WS_QKV && WS_WCAT + (size_t)D * 1280 * 2 <= WS_WO && WS_MERGED + (size_t)M * D * 2 <= WS_Z2, "ws map");
constexpr int CW_BAR = 4096;
constexpr int CW_RWF = 16384;
constexpr size_t WS_HX = 506 * MiB;
constexpr int RING_OFF = 0, RING_BYTES = 131072;
constexpr int LDSCTL_OFF = RING_BYTES, MISC_OFF = LDSCTL_OFF + 320;
constexpr int VEC_OFF = RING_BYTES + 1024;
constexpr int LDS_BYTES = 147456;

#define GAS __attribute__((address_space(1)))
#define LAS __attribute__((address_space(3)))
typedef unsigned short bf16;
typedef unsigned v4u __attribute__((ext_vector_type(4)));
typedef float f32x4 __attribute__((ext_vector_type(4)));
typedef short bf16x8 __attribute__((ext_vector_type(8)));
typedef GAS unsigned gu32;
typedef GAS unsigned long long gu64;
#define RLX_AGENT __ATOMIC_RELAXED, __HIP_MEMORY_SCOPE_AGENT
#define LDS_WAIT() asm volatile("s_waitcnt lgkmcnt(0)" ::: "memory")
#define VM_WAIT() asm volatile("s_waitcnt vmcnt(0)" ::: "memory")
__device__ __forceinline__ unsigned long long rt() { return __builtin_amdgcn_s_memrealtime(); }
__device__ __forceinline__ unsigned f2bf(float f) { unsigned u = __builtin_bit_cast(unsigned, f); return (u + 0x7fffu + ((u >> 16) & 1u)) >> 16; }
typedef float f32x2_t __attribute__((ext_vector_type(2))); typedef __bf16 bf16x2_t __attribute__((ext_vector_type(2)));
__device__ __forceinline__ unsigned pk2(float lo, float hi) { f32x2_t v = {lo, hi}; bf16x2_t b = __builtin_convertvector(v, bf16x2_t); return __builtin_bit_cast(unsigned, b); }

#define XB_TMO      128
#define XB_XCNT(j)  (256  + 64 * (j))
#define XB_XSUB(j)  (1280 + 64 * (j))
#define XB_XGEN(j)  (2304 + 64 * (j))
#define XB_TOP      3328
#define XB_TOPGEN   3392
#define XCD_BAR_WORDS 3456
#define XB_SPIN_CAP (1u << 18)

__device__ __forceinline__ unsigned xb_ld(unsigned* p)              { return __hip_atomic_load(p, __ATOMIC_RELAXED, __HIP_MEMORY_SCOPE_AGENT); }
__device__ __forceinline__ unsigned xb_add(unsigned* p, unsigned v) { return __hip_atomic_fetch_add(p, v, __ATOMIC_RELAXED, __HIP_MEMORY_SCOPE_AGENT); }
__device__ __forceinline__ unsigned xb_xcc_id() { return (unsigned)__builtin_amdgcn_s_getreg((3 << 11) | 20) & 0xFu; }
#define XB_SPIN(cond, bar) do { unsigned _sp = 0; while (cond) { __builtin_amdgcn_s_sleep(1); \
    if ((++_sp & 255u) == 0u) { if (xb_ld(&(bar)[XB_TMO])) break; if (_sp > XB_SPIN_CAP) { atomicAdd(&(bar)[XB_TMO], 1u); break; } } } } while (0)

struct XcdBarrier {
    unsigned* bar; unsigned x;
    volatile LAS unsigned* st;
};

__device__ __forceinline__ XcdBarrier xcd_barrier_post(unsigned* bar, volatile LAS unsigned* st) {
    XcdBarrier b; b.bar = bar; b.x = xb_xcc_id(); b.st = st;
    if (threadIdx.x == 0) (void)xb_add(&bar[XB_XCNT(b.x)], 1u);
    return b;
}
__device__ __forceinline__ void xcd_barrier_complete(unsigned* bar, unsigned x, unsigned& nloc, unsigned& nx) {
    const unsigned G = gridDim.x * gridDim.y * gridDim.z;
    unsigned sum, cnt, mine, sp = 0u;
    for (;;) {
        sum = 0u; cnt = 0u; mine = 0u;
#pragma unroll
        for (unsigned j = 0; j < 16; ++j) { const unsigned c = xb_ld(&bar[XB_XCNT(j)]); sum += c; cnt += (c > 0u) ? 1u : 0u; mine = (j == x) ? c : mine; }
        if (sum == G) break;
        __builtin_amdgcn_s_sleep(1);
        if ((++sp & 255u) == 0u) { if (xb_ld(&bar[XB_TMO])) break; if (sp > XB_SPIN_CAP) { atomicAdd(&bar[XB_TMO], 1u); break; } }
    }
    nloc = mine > 0u ? mine : 1u; nx = cnt > 0u ? cnt : 1u;
}

__device__ __forceinline__ void xcd_barrier(const XcdBarrier& b) {
    asm volatile("s_waitcnt vmcnt(0)" ::: "memory");
    __syncthreads();
    if (threadIdx.x == 0) {
        unsigned* bar = b.bar;
        __builtin_amdgcn_s_waitcnt(0);
        unsigned nloc = b.st[0], nx = b.st[1];
        if (nloc == 0u) { xcd_barrier_complete(bar, b.x, nloc, nx); b.st[0] = nloc; b.st[1] = nx; }
        const unsigned old = xb_add(&bar[XB_XSUB(b.x)], 1u);
        const unsigned gen = old / nloc;
        if (old + 1u == (gen + 1u) * nloc) {
            __builtin_amdgcn_fence(__ATOMIC_RELEASE, "agent");
            asm volatile("s_waitcnt vmcnt(0)" ::: "memory");
            const unsigned og = xb_add(&bar[XB_TOP], 1u);
            const unsigned tg = og / nx;
            if (og + 1u == (tg + 1u) * nx) xb_add(&bar[XB_TOPGEN], 1u);
            else XB_SPIN(xb_ld(&bar[XB_TOPGEN]) == tg, bar);
            __builtin_amdgcn_fence(__ATOMIC_ACQUIRE, "agent");
            xb_add(&bar[XB_XGEN(b.x)], 1u);
            asm volatile("s_waitcnt vmcnt(0)" ::: "memory");
        } else {
            XB_SPIN(xb_ld(&bar[XB_XGEN(b.x)]) == gen, bar);
            __builtin_amdgcn_fence(__ATOMIC_ACQUIRE, "agent");
            asm volatile("s_waitcnt vmcnt(0)" ::: "memory");
        }
    }
    __syncthreads();
}
struct Frame {
    LAS unsigned char* lds;
    volatile LAS unsigned* MISC;
    gu32* ctl;
    int tid, lane, wave;
    int vcu, G;
};
struct Args { const float* in[NIN_T]; float* out; unsigned char* ws; };
__device__ __forceinline__ float wave_sum(float v) {
#pragma unroll
    for (int o = 1; o < 64; o <<= 1) v += __shfl_xor(v, o);
    return v;
}
__device__ __forceinline__ float wave_max(float v) {
#pragma unroll
    for (int o = 1; o < 64; o <<= 1) v = fmaxf(v, __shfl_xor(v, o));
    return v;
}
__device__ __forceinline__ float bf2f(unsigned short b) { return __uint_as_float(((unsigned)b) << 16); }
__device__ __forceinline__ unsigned short f2bf16(float f) { return (unsigned short)(pk2(f, 0.f) & 0xffffu); }

struct TrItem { const float* W; bf16* WT; int K, N, ldw, koff, item; };
__device__ __forceinline__ void tr_load(const TrItem& it, int lane, f32x4 (&v)[8]) {
    const int nblk = it.N / 32, kb = it.item / nblk, nb = it.item % nblk, k0 = 64 * kb, n0 = 32 * nb;
#pragma unroll
    for (int i = 0; i < 8; ++i) { const int kk = 8 * i + (lane >> 3), nn = 4 * (lane & 7); v[i] = *(const GAS f32x4*)(it.W + (size_t)(k0 + kk) * it.N + n0 + nn); }
}
__device__ __forceinline__ void tr_finish(const TrItem& it, int lane, const f32x4 (&v)[8], LAS float* scr) {
    const int nblk = it.N / 32, kb = it.item / nblk, nb = it.item % nblk, k0 = 64 * kb, n0 = 32 * nb;
#pragma unroll
    for (int i = 0; i < 8; ++i) { const int kk = 8 * i + (lane >> 3), nn = 4 * (lane & 7); scr[kk * 33 + nn] = v[i].x; scr[kk * 33 + nn + 1] = v[i].y; scr[kk * 33 + nn + 2] = v[i].z; scr[kk * 33 + nn + 3] = v[i].w; }
    LDS_WAIT(); asm volatile("" ::: "memory");
    const int c = lane & 7;
#pragma unroll
    for (int j = 0; j < 4; ++j) { const int n = (lane >> 3) + 8 * j; const LAS float* s = scr + (8 * c) * 33 + n;
        v4u o; o.x = pk2(s[0 * 33], s[1 * 33]); o.y = pk2(s[2 * 33], s[3 * 33]); o.z = pk2(s[4 * 33], s[5 * 33]); o.w = pk2(s[6 * 33], s[7 * 33]);
        *(GAS v4u*)(it.WT + (size_t)(n0 + n) * it.ldw + it.koff + k0 + 8 * c) = o; }
    LDS_WAIT(); asm volatile("" ::: "memory");
}
template <int NR>
__device__ __forceinline__ void rms_rows_to_bf16(int lane, const float* xrow, size_t rstride, const float* g, bf16* orow) {
    const GAS f32x4* gr = (const GAS f32x4*)g + lane;
    f32x4 v[NR][4]; float s[NR];
#pragma unroll
    for (int r = 0; r < NR; ++r) { const GAS f32x4* xr = (const GAS f32x4*)(xrow + r * rstride) + lane;
#pragma unroll
        for (int j = 0; j < 4; ++j) v[r][j] = xr[64 * j]; }
#pragma unroll
    for (int r = 0; r < NR; ++r) { s[r] = 0.f;
#pragma unroll
        for (int j = 0; j < 4; ++j) s[r] += (v[r][j].x * v[r][j].x + v[r][j].y * v[r][j].y) + (v[r][j].z * v[r][j].z + v[r][j].w * v[r][j].w); }
#pragma unroll
    for (int r = 0; r < NR; ++r) { const float rs = 1.0f / sqrtf(wave_sum(s[r]) * (1.f / D) + NORM_EPS);
        GAS unsigned long long* o8 = (GAS unsigned long long*)(orow + r * rstride) + lane;
#pragma unroll
        for (int j = 0; j < 4; ++j) { const f32x4 gg = gr[64 * j];
            o8[64 * j] = (unsigned long long)pk2(v[r][j].x * rs * gg.x, v[r][j].y * rs * gg.y) | ((unsigned long long)pk2(v[r][j].z * rs * gg.z, v[r][j].w * rs * gg.w) << 32); } }
}
template <int PART>
__device__ __forceinline__ void p0_prologue(Frame& F, const Args& A) {
    LAS float* scr = (LAS float*)(F.lds + RING_OFF + F.wave * 16384);
    const int gw = F.vcu * NWAVES + F.wave, NGW = F.G * NWAVES;
    bf16* WinT = (bf16*)(A.ws + WS_WIN); bf16* WcT = (bf16*)(A.ws + WS_WCAT); bf16* WoT = (bf16*)(A.ws + WS_WO);
    bf16* W1T = (bf16*)(A.ws + WS_W1); bf16* W2T = (bf16*)(A.ws + WS_W2);
    constexpr int I_IN = (D / 64) * (NIN / 32), I_A = (AO / 64) * (D / 32), I_R = (D / 64) * (D / 32), I_O = I_R, I_1 = (D / 64) * (FF / 32), I_2 = (FF / 64) * (D / 32);
    constexpr int NITEMS = I_IN + I_A + I_R + I_O + I_1 + I_2;
    auto mk = [&](int it) { TrItem t; int r = it;
        if (r < I_IN) { t = TrItem{A.in[6], WinT, D, NIN, D, 0, r}; return t; } r -= I_IN;
        if (r < I_A) { t = TrItem{A.in[19], WcT, AO, D, 1280, 0, r}; return t; } r -= I_A;
        if (r < I_R) { t = TrItem{A.in[20], WcT, D, D, 1280, 256, r}; return t; } r -= I_R;
        if (r < I_O) { t = TrItem{A.in[21], WoT, D, D, D, 0, r}; return t; } r -= I_O;
        if (r < I_1) { t = TrItem{A.in[22], W1T, D, FF, D, 0, r}; return t; } r -= I_1;
        t = TrItem{A.in[23], W2T, FF, D, FF, 0, r}; return t; };
    { constexpr int LO = PART == 0 ? 0 : I_IN, HI = PART == 0 ? I_IN : NITEMS;
      f32x4 va[8], vb[8]; int it = LO + gw;
      if (it < HI) { tr_load(mk(it), F.lane, va); }
      for (; it < HI; it += 2 * NGW) {
          if (it + NGW < HI) tr_load(mk(it + NGW), F.lane, vb);
          tr_finish(mk(it), F.lane, va, scr);
          if (it + 2 * NGW < HI) tr_load(mk(it + 2 * NGW), F.lane, va);
          if (it + NGW < HI) tr_finish(mk(it + NGW), F.lane, vb, scr); } }
    if (PART == 1) return;
    bf16* XN = (bf16*)(A.ws + WS_XN);
    for (int m = 2 * gw; m < M; m += 2 * NGW) rms_rows_to_bf16<2>(F.lane, A.in[0] + (size_t)m * D, D, A.in[2], XN + (size_t)m * D);
    { bf16* WwT = (bf16*)(A.ws + WS_LORA); bf16* WaT = (bf16*)(A.ws + WS_LORA + 131072); bf16* WgT = (bf16*)(A.ws + WS_LORA + 262144);
      const int gt = F.vcu * NWAVES * 64 + F.tid, NT = F.G * NWAVES * 64;
      for (int idx = gt; idx < 65536; idx += NT) { const int hh = idx >> 12, c = (idx >> 6) & 63, m = idx & 63; WwT[idx] = f2bf16(A.in[10][(size_t)m * 1024 + hh * 64 + c]); WaT[idx] = f2bf16(A.in[12][(size_t)m * 1024 + hh * 64 + c]); }
      for (int idx = gt; idx < 131072; idx += NT) { const int hh = idx >> 13, c = (idx >> 7) & 63, m = idx & 127; WgT[idx] = f2bf16(A.in[13][(size_t)m * 1024 + hh * 64 + c]); } }
    if (blockIdx.x == 0) {
        float* bt = (float*)(A.ws + WS_SMALL);
        for (int idx = F.tid; idx < 3 * 4 * 129; idx += NWAVES * 64) {
            const int g = idx / (4 * 129), hh = (idx / 129) % 4, j = idx % 129; const int dist = j << (2 * g);
            int bucket;
            if (dist < 16) bucket = dist;
            else { const float df = (float)dist; int large = 16 + (int)(logf(df / 16.0f) / 4.852030263919617f * 16.0f); bucket = large < 31 ? large : 31; }
            bt[idx] = A.in[1][bucket * 12 + g * 4 + hh] * LOG2E;
        }
    }
}

namespace att {
typedef short v4i16 __attribute__((ext_vector_type(4)));
typedef float f32x16 __attribute__((ext_vector_type(16)));
typedef short s16x8 __attribute__((ext_vector_type(8)));
constexpr int K_OFF = 0, V_OFF = 49152, REV_OFF = 98304, WSF_OFF = 99328, OST_OFF = 100352, LDS_USED = 100352 + 16384;
static_assert(LDS_USED <= RING_BYTES, "attention LDS map");
constexpr int NUNITS = BATCH * 4 * 48;
__device__ __forceinline__ int crow(int r, int hi) { return (r & 3) + 8 * (r >> 2) + 4 * hi; }
__device__ __forceinline__ v4i16 vtr(const LAS unsigned char* p) { return __builtin_amdgcn_ds_read_tr16_b64_v4i16((LAS v4i16*)p); }
struct UnitDesc { int b, hh, g, dsh, r, blk, S0, head; };
__device__ __forceinline__ UnitDesc decode_unit(int u) { UnitDesc d; d.b = u / 192; const int rem = u % 192; d.hh = rem / 48; const int x = rem % 48; d.g = x >> 4; const int y = x & 15;
    d.dsh = 2 * d.g; d.r = (d.g == 0) ? 0 : (d.g == 1 ? (y >> 2) : y); d.blk = (d.g == 0) ? y : (d.g == 1 ? (y & 3) : 0); d.S0 = d.blk * 256; d.head = d.g * 4 + d.hh; return d; }
__device__ __forceinline__ void attn_phase(LAS unsigned char* lds, const bf16* QKV, const float* bias2, bf16* OPART, float* LSE, int u0, int ustep, int wave_) {
    const int lane = lane_fresh(), tid = (wave_ << 6) | lane, l31 = lane & 31, hi = lane >> 5, wid = wave_;
    LAS float* REV = (LAS float*)(lds + REV_OFF); LAS float* WSF = (LAS float*)(lds + WSF_OFF);
    v4u kr[6], vr[6]; s16x8 qr[4];
#define ATT_LOAD(uu) do { const UnitDesc d_ = decode_unit(uu); const size_t rb_ = (size_t)d_.b * SEQ; \
        _Pragma("unroll") for (int c = 0; c < 6; ++c) { const int idx = tid + 512 * c, row = idx >> 3, ch = idx & 7; int s_ = d_.S0 - 128 + row; s_ = s_ < 0 ? 0 : s_; const int t_ = (s_ << d_.dsh) + d_.r; \
            const bf16* gp = QKV + (rb_ + t_) * NQKV + 768 + d_.head * 64 + ch * 8; kr[c] = *(const GAS v4u*)gp; vr[c] = *(const GAS v4u*)(gp + 768); } \
        { const int t_ = ((d_.S0 + 32 * wid + l31) << d_.dsh) + d_.r; const bf16* qp = QKV + (rb_ + t_) * NQKV + d_.head * 64 + 8 * hi; \
          _Pragma("unroll") for (int ks = 0; ks < 4; ++ks) qr[ks] = *(const GAS s16x8*)(qp + 16 * ks); } } while (0)
    if (u0 < NUNITS) ATT_LOAD(u0);
    for (int u = u0; u < NUNITS; u += ustep) {
        const UnitDesc d = decode_unit(u); const int b = d.b, hh = d.hh, g = d.g, dsh = d.dsh, r = d.r, blk = d.blk, S0 = d.S0;
        const size_t rowbase = (size_t)b * SEQ;
        if (tid < 224) { const int uu = tid - 32; REV[tid] = (uu >= 0 && uu <= 128) ? bias2[(g * 4 + hh) * 129 + 128 - uu] : -INFINITY; }
#pragma unroll
        for (int c = 0; c < 6; ++c) { const int idx = tid + 512 * c, row = idx >> 3, ch = idx & 7; const int off = row * 128 + ((ch ^ (row & 7)) << 4);
            *(LAS v4u*)(lds + K_OFF + off) = kr[c]; *(LAS v4u*)(lds + V_OFF + off) = vr[c]; }
        s16x8 qc[4];
#pragma unroll
        for (int ks = 0; ks < 4; ++ks) qc[ks] = qr[ks];
        __syncthreads();
        if (u + ustep < NUNITS) ATT_LOAD(u + ustep);
        f32x16 p[5];
#pragma unroll
        for (int kt = 0; kt < 5; ++kt) {
            const int rowk = 32 * wid + 32 * kt + l31; const LAS unsigned char* kb = lds + K_OFF + rowk * 128;
            f32x16 acc = {0.f, 0.f, 0.f, 0.f, 0.f, 0.f, 0.f, 0.f, 0.f, 0.f, 0.f, 0.f, 0.f, 0.f, 0.f, 0.f};
#pragma unroll
            for (int ks = 0; ks < 4; ++ks) { const s16x8 kf = *(const LAS s16x8*)(kb + (((2 * ks + hi) ^ (rowk & 7)) << 4)); acc = __builtin_amdgcn_mfma_f32_32x32x16_bf16(kf, qc[ks], acc, 0, 0, 0); }
            const LAS float* rv = REV + 32 + 32 * kt + 4 * hi - l31;
            const float deadv = ((blk == 0) && (wid + kt < 4)) ? -INFINITY : 0.f;
#pragma unroll
            for (int rg = 0; rg < 16; ++rg) { const float bv = rv[(rg & 3) + 8 * (rg >> 2)]; acc[rg] = (acc[rg] + bv) + deadv; }
            p[kt] = acc;
        }
        float m = p[0][0];
#pragma unroll
        for (int kt = 0; kt < 5; ++kt)
#pragma unroll
            for (int rg = 0; rg < 16; ++rg) m = fmaxf(m, p[kt][rg]);
        m = fmaxf(m, __shfl_xor(m, 32));
        float l = 0.f;
#pragma unroll
        for (int kt = 0; kt < 5; ++kt)
#pragma unroll
            for (int rg = 0; rg < 16; ++rg) { const float e = __builtin_amdgcn_exp2f(p[kt][rg] - m); p[kt][rg] = e; l += e; }
        l += __shfl_xor(l, 32);
        if (hi == 0) { WSF[wid * 32 + l31] = l; const int t = ((S0 + 32 * wid + l31) << dsh) + r; LSE[((size_t)g * M + rowbase + t) * 4 + hh] = m + __builtin_amdgcn_logf(l); }
        f32x16 z[2];
#pragma unroll
        for (int db = 0; db < 2; ++db) z[db] = (f32x16){0.f, 0.f, 0.f, 0.f, 0.f, 0.f, 0.f, 0.f, 0.f, 0.f, 0.f, 0.f, 0.f, 0.f, 0.f, 0.f};
        const int q4 = (lane & 15) >> 2, c2 = 2 * ((lane >> 4) & 1) + ((lane & 3) >> 1), sw = 4 * hi + q4;
#pragma unroll
        for (int kt = 0; kt < 5; ++kt)
#pragma unroll
            for (int s = 0; s < 2; ++s) {
                s16x8 pa;
#pragma unroll
                for (int e = 0; e < 4; ++e) { const unsigned w = pk2(p[kt][8 * s + 2 * e], p[kt][8 * s + 2 * e + 1]); pa[2 * e] = (short)(w & 0xffffu); pa[2 * e + 1] = (short)(w >> 16); }
                const int vrow = 32 * wid + 32 * kt + 16 * s + 4 * hi + q4;
#pragma unroll
                for (int db = 0; db < 2; ++db) {
                    const LAS unsigned char* vp = lds + V_OFF + vrow * 128 + (((4 * db + c2) ^ sw) << 4) + 8 * (lane & 1);
                    const v4i16 lo = vtr(vp), hi4 = vtr(vp + 8 * 128);
                    const s16x8 vf = (s16x8){lo[0], lo[1], lo[2], lo[3], hi4[0], hi4[1], hi4[2], hi4[3]};
                    z[db] = __builtin_amdgcn_mfma_f32_32x32x16_bf16(pa, vf, z[db], 0, 0, 0);
                }
            }
        { LAS unsigned short* stg = (LAS unsigned short*)(lds + OST_OFF) + wid * 1024;
#pragma unroll
          for (int hf = 0; hf < 2; ++hf) {
#pragma unroll
              for (int k = 0; k < 8; ++k) { const int rg = 8 * hf + k, q = crow(rg, hi); const float rl = __builtin_amdgcn_rcpf(WSF[wid * 32 + q]);
                  stg[(q & 15) * 64 + l31] = f2bf16(z[0][rg] * rl); stg[(q & 15) * 64 + 32 + l31] = f2bf16(z[1][rg] * rl); }
#pragma unroll
              for (int i = 0; i < 2; ++i) { const int q15 = i * 8 + (lane >> 3), ch = lane & 7; const v4u v = *(const LAS v4u*)(stg + q15 * 64 + ch * 8); const int t = ((S0 + 32 * wid + 16 * hf + q15) << dsh) + r;
                  *(GAS v4u*)(OPART + ((size_t)g * M + rowbase + t) * AO + hh * 64 + ch * 8) = v; } } }
        __syncthreads();
    }
#undef ATT_LOAD
}
__device__ __forceinline__ void attn_combine(const bf16* OPART, const float* LSE, bf16* OATT, int gthread, int nthreads) {
    for (int it = gthread; it < M * 32; it += nthreads) { const int bt = it >> 5, c8 = it & 31, hh = c8 >> 3;
        const float l0 = LSE[((size_t)0 * M + bt) * 4 + hh], l1 = LSE[((size_t)1 * M + bt) * 4 + hh], l2 = LSE[((size_t)2 * M + bt) * 4 + hh];
        const float mx = fmaxf(l0, fmaxf(l1, l2)); float w0 = __builtin_amdgcn_exp2f(l0 - mx), w1 = __builtin_amdgcn_exp2f(l1 - mx), w2 = __builtin_amdgcn_exp2f(l2 - mx);
        const float inv = 1.0f / (w0 + w1 + w2); w0 *= inv; w1 *= inv; w2 *= inv;
        const v4u a = *(const GAS v4u*)(OPART + ((size_t)0 * M + bt) * AO + c8 * 8), bq = *(const GAS v4u*)(OPART + ((size_t)1 * M + bt) * AO + c8 * 8), c = *(const GAS v4u*)(OPART + ((size_t)2 * M + bt) * AO + c8 * 8);
        const unsigned aw[4] = {a.x, a.y, a.z, a.w}, bw[4] = {bq.x, bq.y, bq.z, bq.w}, cw[4] = {c.x, c.y, c.z, c.w}; unsigned ow[4];
#pragma unroll
        for (int e = 0; e < 4; ++e) { const float lo = w0 * __uint_as_float(aw[e] << 16) + w1 * __uint_as_float(bw[e] << 16) + w2 * __uint_as_float(cw[e] << 16);
            const float hi_ = w0 * __uint_as_float(aw[e] & 0xffff0000u) + w1 * __uint_as_float(bw[e] & 0xffff0000u) + w2 * __uint_as_float(cw[e] & 0xffff0000u); ow[e] = pk2(lo, hi_); }
        *(GAS v4u*)(OATT + (size_t)bt * 1280 + c8 * 8) = (v4u){ow[0], ow[1], ow[2], ow[3]}; }
}
}


__device__ __forceinline__ void xs_prepass(const bf16* Fm, const float* mu, bf16* XS, int gthread, int nthreads) {
    for (int it = gthread; it < M * 32; it += nthreads) { const int bt = it >> 5, ch = it & 31, t = bt & (SEQ - 1), gcol = 3072 + ch * 8, kind = ch >> 3;
        const v4u cur = *(const GAS v4u*)(Fm + (size_t)bt * NF + gcol); v4u prv = (v4u){0u, 0u, 0u, 0u}; if (t > 0) prv = *(const GAS v4u*)(Fm + (size_t)(bt - 1) * NF + gcol);
        const f32x4 m0 = *(const GAS f32x4*)(mu + gcol), m1 = *(const GAS f32x4*)(mu + gcol + 4);
        const unsigned cw[4] = {cur.x, cur.y, cur.z, cur.w}, pw[4] = {prv.x, prv.y, prv.z, prv.w}; const float mm[8] = {m0.x, m0.y, m0.z, m0.w, m1.x, m1.y, m1.z, m1.w}; float xs[8];
#pragma unroll
        for (int e = 0; e < 4; ++e) { const float c0 = __uint_as_float(cw[e] << 16), c1 = __uint_as_float(cw[e] & 0xffff0000u), p0 = __uint_as_float(pw[e] << 16), p1 = __uint_as_float(pw[e] & 0xffff0000u);
            xs[2 * e] = c0 + (p0 - c0) * mm[2 * e]; xs[2 * e + 1] = c1 + (p1 - c1) * mm[2 * e + 1]; }
        const float sc = kind == 0 ? 2.0f : 1.0f;
#pragma unroll
        for (int e = 0; e < 8; ++e) { const float y = __builtin_amdgcn_rcpf(1.0f + __builtin_amdgcn_exp2f(-LOG2E * sc * xs[e])); xs[e] = kind == 0 ? 2.0f * y - 1.0f : (kind == 1 ? xs[e] : y); }
        *(GAS v4u*)(XS + (size_t)bt * 256 + ch * 8) = (v4u){pk2(xs[0], xs[1]), pk2(xs[2], xs[3]), pk2(xs[4], xs[5]), pk2(xs[6], xs[7])}; }
}
namespace rw {
typedef short s16x8 __attribute__((ext_vector_type(8)));
typedef short v4i16 __attribute__((ext_vector_type(4)));
typedef float f32x16 __attribute__((ext_vector_type(16)));
constexpr int U = 9216, PT = 144;
constexpr int O_R = 0 * U, O_K = 1 * U, O_V = 2 * U, O_TW = 3 * U, O_FA = 4 * U, O_SG0 = 5 * U, O_SG1 = 6 * U, O_LW = 7 * U  , O_AA = 9 * U, O_GD = 10 * U, O_ARB = 11 * U, O_ARK = 12 * U, O_XT2 = 13 * U;
constexpr int O_AT = O_R, O_RT = O_K, O_BH = O_TW, O_KH = O_FA, O_BB = O_SG0, O_KB = O_SG1, O_ABT = O_LW  , O_AAK = O_AA, O_XT1 = O_AA;
constexpr int O_PF = O_R, O_QF = O_TW, O_GT = O_FA, O_Y0T = O_LW;
constexpr int O_TD = 14 * U;
constexpr int O_MISC = 131072 + 1024;
constexpr int M_W0 = 0, M_A0 = 64, M_KK = 128, M_KA = 192, M_RK = 256, M_LNW = 320, M_LNB = 384, M_INV = 448, M_BON = 512, M_GC = 576, M_CUMC = 640, M_SEGT = 704, M_SEGO = 1216, M_STAT = 1728, M_MU = 1984, M_CNT = 2432;
constexpr int O_TB = (O_MISC + (M_CNT + 1) * 4 + 15) & ~15;
static_assert(O_TD + 2048 <= 131072 && O_TB + 2 * 2560 <= LDS_BYTES && 16384 <= 2 * U, "rwkv lds map");
__device__ __forceinline__ int crow(int r, int hi) { return (r & 3) + 8 * (r >> 2) + 4 * hi; }
__device__ __forceinline__ int boff(int row, int col) { return row * PT + col * 2; }
__device__ __forceinline__ float fsig(float x) { return __builtin_amdgcn_rcpf(1.0f + __builtin_amdgcn_exp2f(-LOG2E * x)); }
__device__ __forceinline__ float fexp(float x) { return __builtin_amdgcn_exp2f(LOG2E * x); }
#define RW_DPP(v, ctrl) __builtin_bit_cast(float, __builtin_amdgcn_update_dpp(0, __builtin_bit_cast(int, (v)), (ctrl), 0xf, 0xf, true))
__device__ __forceinline__ float sum8(float v) { v += RW_DPP(v, 0xB1); v += RW_DPP(v, 0x4E); v += RW_DPP(v, 0x141); return v; }
__device__ __forceinline__ unsigned long long pk4(float a, float b, float c, float d) { return (unsigned long long)pk2(a, b) | ((unsigned long long)pk2(c, d) << 32); }
__device__ __forceinline__ f32x4 up4(unsigned long long w) { const unsigned lo = (unsigned)w, hi = (unsigned)(w >> 32); return (f32x4){__uint_as_float(lo << 16), __uint_as_float(lo & 0xffff0000u), __uint_as_float(hi << 16), __uint_as_float(hi & 0xffff0000u)}; }
__device__ __forceinline__ s16x8 pack8(const f32x16& a, int s) { s16x8 r;
#pragma unroll
    for (int e = 0; e < 4; ++e) { const unsigned w = pk2(a[8 * s + 2 * e], a[8 * s + 2 * e + 1]); r[2 * e] = (short)(w & 0xffffu); r[2 * e + 1] = (short)(w >> 16); }
    return r; }
__device__ __forceinline__ s16x8 fragN(const LAS unsigned char* Mt, int row0, int ks, int l31, int hi) { return *(const LAS s16x8*)(Mt + (l31 * PT + hi * 16) + (row0 * PT + ks * 32)); }
__device__ __forceinline__ s16x8 fragT(const LAS unsigned char* Mt, int ch0, int ks, int lane) {
    const int g = lane >> 4, q = (lane & 15) >> 2, p = lane & 3;
    const LAS unsigned char* a0 = Mt + ((8 * (g >> 1) + q) * PT + (16 * (g & 1) + 4 * p) * 2) + (16 * ks * PT + ch0 * 2);
    const v4i16 lo = __builtin_amdgcn_ds_read_tr16_b64_v4i16((LAS v4i16*)a0), hi4 = __builtin_amdgcn_ds_read_tr16_b64_v4i16((LAS v4i16*)(a0 + 4 * PT));
    return (s16x8){lo[0], lo[1], lo[2], lo[3], hi4[0], hi4[1], hi4[2], hi4[3]}; }
#define RW_ZERO16 (f32x16){0.f, 0.f, 0.f, 0.f, 0.f, 0.f, 0.f, 0.f, 0.f, 0.f, 0.f, 0.f, 0.f, 0.f, 0.f, 0.f}
#define RW_MMA(acc, AF, BF) do { _Pragma("unroll") for (int ks_ = 0; ks_ < 4; ++ks_) { const int ks = ks_; acc = __builtin_amdgcn_mfma_f32_32x32x16_bf16(AF, BF, acc, 0, 0, 0); } } while (0)
__device__ __forceinline__ void ctile(LAS unsigned char* lds, int type, int tb, int sb, int l31, int hi) {
    const int t = 32 * tb + l31;
    const LAS unsigned char* Am = lds + ((type & 1) ? O_KH : O_BH); const LAS unsigned char* Bm = lds + ((type & 2) ? O_RT : O_AT); const bool incl = (type & 2) != 0;
    f32x16 acc = RW_ZERO16;
    if (sb <= tb) RW_MMA(acc, fragN(Am, 32 * sb, ks, l31, hi), fragN(Bm, 32 * tb, ks, l31, hi));
    const int lim = (sb < tb) ? 64 : ((sb == tb) ? (incl ? l31 + 1 : l31) : 0);
#pragma unroll
    for (int q = 0; q < 4; ++q) { const int s0 = 32 * sb + 8 * q + 4 * hi; float o[4];
#pragma unroll
        for (int e = 0; e < 4; ++e) { const int sl = 8 * q + 4 * hi + e; o[e] = (sl < lim) ? acc[4 * q + e] : 0.f; }
        if (type == 0) {
#pragma unroll
            for (int e = 0; e < 4; ++e) *(LAS float*)(lds + O_ABT + (s0 + e) * 256 + t * 4) = o[e];
        } else { const int dst = type == 1 ? O_AAK : (type == 2 ? O_ARB : O_ARK); *(LAS unsigned long long*)(lds + dst + boff(t, s0)) = pk4(o[0], o[1], o[2], o[3]); } }
}
__device__ __forceinline__ void rwkv_chain(LAS unsigned char* lds, const Args& A, int chain, int wave_, int par, int nW) {
    const int tid0 = (wave_ << 6) | lane_fresh();
    const int b = chain >> 4, h = chain & 15;
    const bf16* Fm = (const bf16*)(A.ws + WS_F); bf16* ORW = (bf16*)(A.ws + WS_ACAT) + 256;
    LAS float* MS = (LAS float*)(lds + O_MISC);
    s16x8 lw[8];
    { const int tid = tid0, lane = tid & 63, l31 = lane & 31, hi = lane >> 5, wid = wave_;
      if (tid == 0) *(LAS unsigned*)(MS + M_CNT) = 0u;
      if (tid < 64) { const int c = h * 64 + tid; MS[M_W0 + tid] = A.in[9][c]; MS[M_A0 + tid] = A.in[11][c]; MS[M_KK + tid] = A.in[14][c]; MS[M_KA + tid] = A.in[15][c];
          MS[M_RK + tid] = A.in[16][c]; MS[M_LNW + tid] = A.in[17][c]; MS[M_LNB + tid] = A.in[18][c]; }
      if (tid < 448) { const int gc = tid < 192 ? (tid >> 6) * 1024 + h * 64 + (tid & 63) : 3072 + (tid - 192); MS[M_MU + tid] = A.in[8][gc]; }
      if (wid < 4) { const int cb = wid >> 1; const bf16* w1 = (const bf16*)(A.ws + WS_LORA) + (size_t)h * 4096 + (size_t)(32 * cb + l31) * 64 + 8 * hi; const bf16* w2 = w1 + 65536;
#pragma unroll
          for (int ks = 0; ks < 4; ++ks) { lw[ks] = *(const GAS s16x8*)(w1 + 16 * ks); lw[4 + ks] = *(const GAS s16x8*)(w2 + 16 * ks); }
      } else { const int ib = (wid - 4) >> 1; const bf16* w3 = (const bf16*)(A.ws + WS_LORA + 262144) + (size_t)h * 8192 + (size_t)(32 * ib + l31) * 128 + 8 * hi;
#pragma unroll
          for (int ks = 0; ks < 8; ++ks) lw[ks] = *(const GAS s16x8*)(w3 + 16 * ks); }
    }
    v4u pc[7], pp[3]; const bf16* XSm = (const bf16*)(A.ws + WS_XS);
#define RW_LOAD(cc) do { _Pragma("unroll") for (int q = 0; q < 7; ++q) { const int idx = tid0 + 512 * q; \
        if (q < 3) { const int row = (idx & 511) >> 3, gcol = q * 1024 + h * 64 + (idx & 7) * 8; const int tl = 64 * (cc) + row; const bf16* gp = Fm + ((size_t)b * SEQ + tl) * NF + gcol; \
            pc[q] = *(const GAS v4u*)gp; pp[q] = (v4u){0u, 0u, 0u, 0u}; if (tl > 0) pp[q] = *(const GAS v4u*)(gp - NF); } \
        else { const int e = idx - 1536; pc[q] = *(const GAS v4u*)(XSm + ((size_t)b * SEQ + 64 * (cc) + (e >> 5)) * 256 + (e & 31) * 8); } } } while (0)
    RW_LOAD(par);
    gu32* flagp = (gu32*)(A.ws + WS_CTL) + CW_RWF + chain * 64;
    unsigned char* hx = A.ws + WS_HX + (size_t)chain * 2 * U;
    __syncthreads();
    for (int c = par; c < SEQ / 64; c += nW) {
        int tidv = tid0; asm volatile("" : "+v"(tidv));
        const int tid = tidv, lane = tid & 63, l31 = lane & 31, hi = lane >> 5, wid = wave_;
#pragma unroll
        for (int q = 0; q < 3; ++q) {
            const int idx = tid + 512 * q, row = (idx & 511) >> 3, ch = idx & 7, mo = q * 64 + ch * 8;
            const f32x4 m0 = *(const LAS f32x4*)(MS + M_MU + mo), m1 = *(const LAS f32x4*)(MS + M_MU + mo + 4);
            const unsigned cw[4] = {pc[q].x, pc[q].y, pc[q].z, pc[q].w}, pw[4] = {pp[q].x, pp[q].y, pp[q].z, pp[q].w}; const float mm[8] = {m0.x, m0.y, m0.z, m0.w, m1.x, m1.y, m1.z, m1.w};
            float xs[8];
#pragma unroll
            for (int e = 0; e < 4; ++e) { const float c0 = __uint_as_float(cw[e] << 16), c1 = __uint_as_float(cw[e] & 0xffff0000u), p0 = __uint_as_float(pw[e] << 16), p1 = __uint_as_float(pw[e] & 0xffff0000u);
                xs[2 * e] = c0 + (p0 - c0) * mm[2 * e]; xs[2 * e + 1] = c1 + (p1 - c1) * mm[2 * e + 1]; }
            const int dst = q == 0 ? O_R : (q == 1 ? O_K : O_V);
            if (q == 1) { float ss = 0.f; const f32x4 k0 = *(const LAS f32x4*)(MS + M_KK + ch * 8), k1 = *(const LAS f32x4*)(MS + M_KK + ch * 8 + 4); const float kq[8] = {k0.x, k0.y, k0.z, k0.w, k1.x, k1.y, k1.z, k1.w};
#pragma unroll
                for (int e = 0; e < 8; ++e) { const float kv = xs[e] * kq[e]; ss += kv * kv; }
                ss = sum8(ss);
                if (ch == 0) MS[M_INV + row] = 1.0f / fmaxf(sqrtf(ss), 1e-12f); }
            *(LAS v4u*)(lds + dst + boff(row, ch * 8)) = (v4u){pk2(xs[0], xs[1]), pk2(xs[2], xs[3]), pk2(xs[4], xs[5]), pk2(xs[6], xs[7])};
        }
#pragma unroll
        for (int q = 3; q < 7; ++q) { const int e = tid + 512 * q - 1536, row = e >> 5, ch = e & 31, kind = ch >> 3; const int dst = kind == 0 ? O_TW : kind == 1 ? O_FA : kind == 2 ? O_SG0 : O_SG1;
            *(LAS v4u*)(lds + dst + boff(row, (ch & 7) * 8)) = pc[q]; }
        if (c + nW < SEQ / 64) RW_LOAD(c + nW);
        __syncthreads();
        if (wid < 4) { const int tb = wid & 1, cb = wid >> 1, t = 32 * tb + l31;
            f32x16 acc = RW_ZERO16; RW_MMA(acc, lw[ks], fragN(lds + O_TW, 32 * tb, ks, l31, hi));
#pragma unroll
            for (int q = 0; q < 4; ++q) { const int c0 = 32 * cb + 8 * q + 4 * hi; const f32x4 w0 = *(const LAS f32x4*)(MS + M_W0 + c0); f32x4 o;
#pragma unroll
                for (int e = 0; e < 4; ++e) o[e] = -0.6065306597126334f * fsig(w0[e] + acc[4 * q + e]);
                *(LAS f32x4*)(lds + O_LW + t * 256 + c0 * 4) = o; }
            acc = RW_ZERO16; RW_MMA(acc, lw[4 + ks], fragN(lds + O_FA, 32 * tb, ks, l31, hi));
#pragma unroll
            for (int q = 0; q < 4; ++q) { const int c0 = 32 * cb + 8 * q + 4 * hi; const f32x4 a0 = *(const LAS f32x4*)(MS + M_A0 + c0);
                *(LAS unsigned long long*)(lds + O_AA + boff(t, c0)) = pk4(fsig(a0[0] + acc[4 * q]), fsig(a0[1] + acc[4 * q + 1]), fsig(a0[2] + acc[4 * q + 2]), fsig(a0[3] + acc[4 * q + 3])); }
        } else { const int w4 = wid - 4, tb = w4 & 1, ib = w4 >> 1;
            f32x16 acc = RW_ZERO16; RW_MMA(acc, lw[ks], fragN(lds + O_SG0, 32 * tb, ks, l31, hi)); RW_MMA(acc, lw[4 + ks], fragN(lds + O_SG1, 32 * tb, ks, l31, hi));
#pragma unroll
            for (int q = 0; q < 4; ++q) *(LAS unsigned long long*)(lds + O_GD + (((ib * 2 + tb) * 4 + q) * 64 + lane) * 8) = pk4(acc[4 * q], acc[4 * q + 1], acc[4 * q + 2], acc[4 * q + 3]);
        }
        __syncthreads();
        { const int cc = tid & 63, seg = tid >> 6; float run = 0.f; LAS float* LW = (LAS float*)(lds + O_LW);
#pragma unroll
            for (int q = 0; q < 8; ++q) { run += LW[(8 * seg + q) * 64 + cc]; LW[(8 * seg + q) * 64 + cc] = run; }
            MS[M_SEGT + seg * 64 + cc] = run; }
        __syncthreads();
        if (tid < 64) { float off = 0.f;
#pragma unroll
            for (int sg = 0; sg < 8; ++sg) { MS[M_SEGO + sg * 64 + tid] = off; off += MS[M_SEGT + sg * 64 + tid]; }
            MS[M_CUMC + tid] = off; MS[M_GC + tid] = fexp(off); }
        __syncthreads();
        { const int t = tid >> 3, jg = tid & 7, j0 = 8 * jg, seg = t >> 3, tp = t > 0 ? t - 1 : 0, segp = tp >> 3; const LAS float* LW = (const LAS float*)(lds + O_LW);
            const v4u rv = *(const LAS v4u*)(lds + O_R + boff(t, j0)), kv = *(const LAS v4u*)(lds + O_K + boff(t, j0)), av = *(const LAS v4u*)(lds + O_AA + boff(t, j0));
            const float inv = MS[M_INV + t]; float at[8], rt[8], bh[8], kh[8], bb[8], kb[8], bon = 0.f;
#pragma unroll
            for (int hf = 0; hf < 2; ++hf) { const int jj = j0 + 4 * hf;
                const f32x4 lwc = *(const LAS f32x4*)(LW + t * 64 + jj), soc = *(const LAS f32x4*)(MS + M_SEGO + seg * 64 + jj), lwp = *(const LAS f32x4*)(LW + tp * 64 + jj), sop = *(const LAS f32x4*)(MS + M_SEGO + segp * 64 + jj);
                const f32x4 gc = *(const LAS f32x4*)(MS + M_GC + jj), kkv = *(const LAS f32x4*)(MS + M_KK + jj), kav = *(const LAS f32x4*)(MS + M_KA + jj), rkv = *(const LAS f32x4*)(MS + M_RK + jj);
                const f32x4 a4 = up4(hf ? ((unsigned long long)av.w << 32 | av.z) : ((unsigned long long)av.y << 32 | av.x)), k4 = up4(hf ? ((unsigned long long)kv.w << 32 | kv.z) : ((unsigned long long)kv.y << 32 | kv.x)),
                            r4 = up4(hf ? ((unsigned long long)rv.w << 32 | rv.z) : ((unsigned long long)rv.y << 32 | rv.x));
#pragma unroll
                for (int e = 0; e < 4; ++e) { const int x = 4 * hf + e;
                    const float cum = lwc[e] + soc[e]; const float cump = t > 0 ? lwp[e] + sop[e] : 0.f;
                    const float e1 = fexp(cum), e0 = fexp(cump), ei = __builtin_amdgcn_rcpf(e1), ec = gc[e] * ei;
                    const float a = a4[e], kraw = k4[e], rr = r4[e];
                    const float kk = kraw * kkv[e] * inv, bq = kk * a, kp = kraw * (1.0f + (a - 1.0f) * kav[e]);
                    at[x] = -kk * e0; rt[x] = rr * e1; bh[x] = bq * ei; kh[x] = kp * ei; bb[x] = bq * ec; kb[x] = kp * ec; bon += rr * kp * rkv[e]; } }
            bon = sum8(bon); if (jg == 0) MS[M_BON + t] = bon;
            const int o = boff(t, j0);
            *(LAS v4u*)(lds + O_AT + o) = (v4u){pk2(at[0], at[1]), pk2(at[2], at[3]), pk2(at[4], at[5]), pk2(at[6], at[7])};
            *(LAS v4u*)(lds + O_RT + o) = (v4u){pk2(rt[0], rt[1]), pk2(rt[2], rt[3]), pk2(rt[4], rt[5]), pk2(rt[6], rt[7])};
            *(LAS v4u*)(lds + O_BH + o) = (v4u){pk2(bh[0], bh[1]), pk2(bh[2], bh[3]), pk2(bh[4], bh[5]), pk2(bh[6], bh[7])};
            *(LAS v4u*)(lds + O_KH + o) = (v4u){pk2(kh[0], kh[1]), pk2(kh[2], kh[3]), pk2(kh[4], kh[5]), pk2(kh[6], kh[7])};
            *(LAS v4u*)(lds + O_BB + o) = (v4u){pk2(bb[0], bb[1]), pk2(bb[2], bb[3]), pk2(bb[4], bb[5]), pk2(bb[6], bb[7])};
            *(LAS v4u*)(lds + O_KB + o) = (v4u){pk2(kb[0], kb[1]), pk2(kb[2], kb[3]), pk2(kb[4], kb[5]), pk2(kb[6], kb[7])}; }
        __syncthreads();
        if (wid < 6) { const int type = wid >= 3 ? 1 : 0, idx = wid - 3 * type;
            ctile(lds, type, idx > 0, idx > 1, l31, hi);
        }
        __syncthreads();
        f32x16 r0 = RW_ZERO16, r1 = RW_ZERO16;
        if (wid < 2) {
            const int B = wid, o16 = lane >> 5, c16 = (lane >> 1) & 15, rh = lane & 1, b16 = 2 * B + o16;
            const LAS float* ABTb = (const LAS float*)(lds + O_ABT) + (16 * b16) * 64 + 16 * b16 + 8 * rh;
            f32x4 aL0[11], aL1[15];
#pragma unroll
            for (int s = 0; s < 15; ++s) { if (s < 11) aL0[s] = *(const LAS f32x4*)(ABTb + s * 64); aL1[s] = *(const LAS f32x4*)(ABTb + s * 64 + 4); }
            float part[8], tsv[16];
#pragma unroll
            for (int e = 0; e < 8; ++e) part[e] = (8 * rh + e == c16) ? 1.f : 0.f;
            const bool zl = (rh == 1) && (o16 == 1);
            LAS unsigned char* TBp = lds + O_TB + B * 2560 + (zl ? (16 + c16) * 2 : (16 * o16) * 80 + (16 * o16 + c16) * 2);
#pragma unroll
            for (int s = 0; s < 16; ++s) {
                const int src = __builtin_bit_cast(int, part[s & 7]);
                const float ts = __builtin_bit_cast(float, s < 8 ? __builtin_amdgcn_update_dpp(src, src, 0xA0, 0xf, 0xf, false) : __builtin_amdgcn_update_dpp(src, src, 0xF5, 0xf, 0xf, false));
                tsv[s] = ts;
                *(LAS unsigned short*)(TBp + s * 80) = zl ? (unsigned short)0 : f2bf16(ts);
                if (s < 11) { part[0] += aL0[s < 11 ? s : 0][0] * ts; part[1] += aL0[s < 11 ? s : 0][1] * ts; part[2] += aL0[s < 11 ? s : 0][2] * ts; part[3] += aL0[s < 11 ? s : 0][3] * ts; }
                if (s < 15) { part[4] += aL1[s < 15 ? s : 0][0] * ts; part[5] += aL1[s < 15 ? s : 0][1] * ts; part[6] += aL1[s < 15 ? s : 0][2] * ts; part[7] += aL1[s < 15 ? s : 0][3] * ts; } }
            { LAS unsigned char* td = lds + O_TD + (b16 * 16 + c16) * 32 + 16 * rh;
              const v4u lo4 = (v4u){pk2(tsv[0], tsv[1]), pk2(tsv[2], tsv[3]), pk2(tsv[4], tsv[5]), pk2(tsv[6], tsv[7])}, hi4 = (v4u){pk2(tsv[8], tsv[9]), pk2(tsv[10], tsv[11]), pk2(tsv[12], tsv[13]), pk2(tsv[14], tsv[15])};
              *(LAS v4u*)td = rh ? hi4 : lo4; }
            const int B2 = l31 >> 4, r15 = l31 & 15; const s16x8 zf = (s16x8){0, 0, 0, 0, 0, 0, 0, 0}; const bool mine = (B2 == B);
            float av[8];
#pragma unroll
            for (int e = 0; e < 8; ++e) av[e] = *((const LAS float*)(lds + O_ABT) + (32 * B + 8 * hi + e) * 64 + 32 * B + 16 + r15);
            const unsigned w0 = pk2(av[0], av[1]), w1 = pk2(av[2], av[3]), w2 = pk2(av[4], av[5]), w3 = pk2(av[6], av[7]);
            const s16x8 a_own = (s16x8){(short)(w0 & 0xffff), (short)(w0 >> 16), (short)(w1 & 0xffff), (short)(w1 >> 16), (short)(w2 & 0xffff), (short)(w2 >> 16), (short)(w3 & 0xffff), (short)(w3 >> 16)};
            const s16x8 b_own = *(const LAS s16x8*)(lds + O_TD + ((2 * B) * 16 + r15) * 32 + 16 * hi);
            f32x16 d = RW_ZERO16;
            d = __builtin_amdgcn_mfma_f32_32x32x16_bf16(mine ? a_own : zf, mine ? b_own : zf, d, 0, 0, 0);
            const LAS unsigned char* tbp = lds + O_TB + B * 2560 + (16 + r15) * 80 + (16 + 4 * hi) * 2;
            const unsigned long long tlo = *(const LAS unsigned long long*)tbp, thi = *(const LAS unsigned long long*)(tbp + 16);
            const s16x8 t_own = (s16x8){(short)(tlo & 0xffff), (short)((tlo >> 16) & 0xffff), (short)((tlo >> 32) & 0xffff), (short)(tlo >> 48), (short)(thi & 0xffff), (short)((thi >> 16) & 0xffff), (short)((thi >> 32) & 0xffff), (short)(thi >> 48)};
            const s16x8 dsel = B ? pack8(d, 1) : pack8(d, 0);
            f32x16 ee = RW_ZERO16;
            ee = __builtin_amdgcn_mfma_f32_32x32x16_bf16(mine ? t_own : zf, dsel, ee, 0, 0, 0);
            if (mine) {
#pragma unroll
                for (int k = 0; k < 8; ++k) { const float val = B ? ee[8 + k] : ee[k]; *(LAS unsigned short*)(lds + O_TB + B * 2560 + (16 + crow(k, hi)) * 80 + r15 * 2) = f2bf16(val); } }
        } else if (wid < 4) {
            ctile(lds, wid, 0, 0, l31, hi); ctile(lds, wid, 0, 1, l31, hi); ctile(lds, wid, 1, 0, l31, hi);
        } else { const int ct = wid - 4;
            if (ct < 2) {
#pragma unroll
                for (int rg = 0; rg < 16; ++rg) { r0[rg] = bf2f(*(const LAS unsigned short*)(lds + O_AT + boff(crow(rg, hi), 32 * ct + l31))); r1[rg] = bf2f(*(const LAS unsigned short*)(lds + O_AT + boff(32 + crow(rg, hi), 32 * ct + l31))); }
                ctile(lds, 2 + ct, 1, 1, l31, hi);
            } else {
#pragma unroll
                for (int ks = 0; ks < 2; ++ks) r0 = __builtin_amdgcn_mfma_f32_32x32x16_bf16(fragN(lds + O_AAK, 0, ks, l31, hi), fragT(lds + O_V, 32 * (ct - 2), ks, lane), r0, 0, 0, 0);
                RW_MMA(r1, fragN(lds + O_AAK, 32, ks, l31, hi), fragT(lds + O_V, 32 * (ct - 2), ks, lane)); }
        }
        __syncthreads();
        if (wid >= 4) { const int ct = wid - 4;
            s16x8 tf[2][2], af[2];
#pragma unroll
            for (int blk = 0; blk < 2; ++blk)
#pragma unroll
                for (int s = 0; s < 2; ++s) { const LAS unsigned char* tp_ = lds + O_TB + blk * 2560 + l31 * 80 + (16 * s + 4 * hi) * 2;
                    const unsigned long long lo = *(const LAS unsigned long long*)tp_, hi8 = *(const LAS unsigned long long*)(tp_ + 16);
                    tf[blk][s] = (s16x8){(short)(lo & 0xffff), (short)((lo >> 16) & 0xffff), (short)((lo >> 32) & 0xffff), (short)(lo >> 48), (short)(hi8 & 0xffff), (short)((hi8 >> 16) & 0xffff), (short)((hi8 >> 32) & 0xffff), (short)(hi8 >> 48)}; }
#pragma unroll
            for (int s = 0; s < 2; ++s) { const LAS float* ap = (const LAS float*)(lds + O_ABT) + (16 * s + 4 * hi) * 64 + 32 + l31; float v[8];
#pragma unroll
                for (int e = 0; e < 8; ++e) v[e] = ap[(8 * (e >> 2) + (e & 3)) * 64];
                const unsigned w0 = pk2(v[0], v[1]), w1 = pk2(v[2], v[3]), w2 = pk2(v[4], v[5]), w3 = pk2(v[6], v[7]);
                af[s] = (s16x8){(short)(w0 & 0xffff), (short)(w0 >> 16), (short)(w1 & 0xffff), (short)(w1 >> 16), (short)(w2 & 0xffff), (short)(w2 >> 16), (short)(w3 & 0xffff), (short)(w3 >> 16)}; }
            f32x16 x0 = RW_ZERO16;
#pragma unroll
            for (int s = 0; s < 2; ++s) x0 = __builtin_amdgcn_mfma_f32_32x32x16_bf16(tf[0][s], pack8(r0, s), x0, 0, 0, 0);
#pragma unroll
            for (int s = 0; s < 2; ++s) r1 = __builtin_amdgcn_mfma_f32_32x32x16_bf16(af[s], pack8(x0, s), r1, 0, 0, 0);
            f32x16 x1 = RW_ZERO16;
#pragma unroll
            for (int s = 0; s < 2; ++s) x1 = __builtin_amdgcn_mfma_f32_32x32x16_bf16(tf[1][s], pack8(r1, s), x1, 0, 0, 0);
            const int dst = (ct < 2 ? O_XT1 : O_XT2), xr = 32 * (ct & 1) + l31;
#pragma unroll
            for (int q = 0; q < 4; ++q) {
                *(LAS unsigned long long*)(lds + dst + boff(xr, 8 * q + 4 * hi)) = pk4(x0[4 * q], x0[4 * q + 1], x0[4 * q + 2], x0[4 * q + 3]);
                *(LAS unsigned long long*)(lds + dst + boff(xr, 32 + 8 * q + 4 * hi)) = pk4(x1[4 * q], x1[4 * q + 1], x1[4 * q + 2], x1[4 * q + 3]); }
        }
        __syncthreads();
        unsigned long long hfr[4][2];
        const int ibx = wid < 4 ? (wid & 1) : ((wid - 4) >> 1);
#define RW_HLOAD() do { const unsigned char* hsrc_ = hx + (c & 1) * U; _Pragma("unroll") for (int f = 0; f < 4; ++f) { gu64* hp = (gu64*)(hsrc_ + ((((f >> 1) * 2 + ibx) * 2 + (f & 1)) * 64 + lane) * 16); \
            hfr[f][0] = __hip_atomic_load(hp, RLX_AGENT); hfr[f][1] = __hip_atomic_load(hp + 1, RLX_AGENT); } } while (0)
#pragma unroll
        for (int f = 0; f < 4; ++f) { hfr[f][0] = 0ull; hfr[f][1] = 0ull; }
        bool hgot = (c == 0);
        if (!hgot && (unsigned)__builtin_amdgcn_readfirstlane(__hip_atomic_load(flagp, RLX_AGENT)) >= (unsigned)c) { RW_HLOAD(); hgot = true; }
        f32x16 yacc;
        if (wid >= 4) { const int w4 = wid - 4, xb = w4 >> 1, tb = w4 & 1, t = 32 * tb + l31;
            s16x8 arb[4];
#pragma unroll
            for (int ks = 0; ks < 4; ++ks) arb[ks] = fragN(lds + O_ARB, 32 * tb, ks, l31, hi);
            f32x16 acc;
#pragma unroll
            for (int q = 0; q < 4; ++q) { const f32x4 rr = up4(*(const LAS unsigned long long*)(lds + O_RT + boff(t, 32 * xb + 8 * q + 4 * hi))); acc[4 * q] = rr[0]; acc[4 * q + 1] = rr[1]; acc[4 * q + 2] = rr[2]; acc[4 * q + 3] = rr[3]; }
            RW_MMA(acc, fragN(lds + O_XT1, 32 * xb, ks, l31, hi), arb[ks]);
#pragma unroll
            for (int s = 0; s < 2; ++s) *(LAS s16x8*)(lds + O_QF + (((xb * 2 + tb) * 2 + s) * 64 + lane) * 16) = pack8(acc, s);
            yacc = RW_ZERO16;
            RW_MMA(yacc, fragN(lds + O_XT2, 32 * xb, ks, l31, hi), arb[ks]); RW_MMA(yacc, fragT(lds + O_V, 32 * xb, ks, lane), fragN(lds + O_ARK, 32 * tb, ks, l31, hi));
        } else { const int jb = wid >> 1, yb = wid & 1;
            f32x16 acc = RW_ZERO16;
            RW_MMA(acc, fragN(lds + O_XT1, 32 * jb, ks, l31, hi), fragT(lds + O_BB, 32 * yb, ks, lane));
            if (jb == yb) { const float gc = MS[M_GC + 32 * jb + l31];
#pragma unroll
                for (int rg = 0; rg < 16; ++rg) if (crow(rg, hi) == l31) acc[rg] += gc; }
#pragma unroll
            for (int s = 0; s < 2; ++s) *(LAS s16x8*)(lds + O_PF + (((yb * 2 + jb) * 2 + s) * 64 + lane) * 16) = pack8(acc, s);
            yacc = RW_ZERO16;
            RW_MMA(yacc, fragT(lds + O_BB, 32 * jb, ks, lane), fragN(lds + O_XT2, 32 * yb, ks, l31, hi)); RW_MMA(yacc, fragT(lds + O_KB, 32 * jb, ks, lane), fragT(lds + O_V, 32 * yb, ks, lane));
        }
        if (!hgot) { unsigned spins = 0;
            while ((unsigned)__builtin_amdgcn_readfirstlane(__hip_atomic_load(flagp, RLX_AGENT)) < (unsigned)c) { __builtin_amdgcn_s_sleep(1); if (++spins > (1u << 22)) break; }
            RW_HLOAD(); }
#undef RW_HLOAD
        __syncthreads();
        unsigned char* HFn = hx + ((c + 1) & 1) * U;
#define RW_HF(jb_, s_) ((s16x8){(short)(hfr[(jb_) * 2 + (s_)][0] & 0xffff), (short)((hfr[(jb_) * 2 + (s_)][0] >> 16) & 0xffff), (short)((hfr[(jb_) * 2 + (s_)][0] >> 32) & 0xffff), (short)(hfr[(jb_) * 2 + (s_)][0] >> 48), (short)(hfr[(jb_) * 2 + (s_)][1] & 0xffff), (short)((hfr[(jb_) * 2 + (s_)][1] >> 16) & 0xffff), (short)((hfr[(jb_) * 2 + (s_)][1] >> 32) & 0xffff), (short)(hfr[(jb_) * 2 + (s_)][1] >> 48)})
        int ib_ = 0, tb_ = 0;
        if (wid < 4) { const int jp = wid >> 1, ib = wid & 1; f32x16 acc = yacc;
#pragma unroll
            for (int jb = 0; jb < 2; ++jb)
#pragma unroll
                for (int s = 0; s < 2; ++s) { const s16x8 pf = *(const LAS s16x8*)(lds + O_PF + (((jp * 2 + jb) * 2 + s) * 64 + lane) * 16); const s16x8 hf = RW_HF(jb, s);
                    acc = __builtin_amdgcn_mfma_f32_32x32x16_bf16(pf, hf, acc, 0, 0, 0); }
            if (c + 1 < SEQ / 64) {
#pragma unroll
                for (int s = 0; s < 2; ++s) { gu64* hp = (gu64*)(HFn + (((jp * 2 + ib) * 2 + s) * 64 + lane) * 16);
                    __hip_atomic_store(hp, (unsigned long long)pk2(acc[8 * s], acc[8 * s + 1]) | ((unsigned long long)pk2(acc[8 * s + 2], acc[8 * s + 3]) << 32), RLX_AGENT);
                    __hip_atomic_store(hp + 1, (unsigned long long)pk2(acc[8 * s + 4], acc[8 * s + 5]) | ((unsigned long long)pk2(acc[8 * s + 6], acc[8 * s + 7]) << 32), RLX_AGENT); }
            }
        } else { const int w4 = wid - 4; ib_ = w4 >> 1; tb_ = w4 & 1;
#pragma unroll
            for (int jb = 0; jb < 2; ++jb)
#pragma unroll
                for (int s = 0; s < 2; ++s) { const s16x8 hf = RW_HF(jb, s); const s16x8 qf = *(const LAS s16x8*)(lds + O_QF + (((jb * 2 + tb_) * 2 + s) * 64 + lane) * 16);
                    yacc = __builtin_amdgcn_mfma_f32_32x32x16_bf16(hf, qf, yacc, 0, 0, 0); }
            float s1 = 0.f, s2 = 0.f;
#pragma unroll
            for (int rg = 0; rg < 16; ++rg) { s1 += yacc[rg]; s2 += yacc[rg] * yacc[rg]; }
            s1 += __shfl_xor(s1, 32); s2 += __shfl_xor(s2, 32);
            if (hi == 0) { MS[M_STAT + ((tb_ * 2 + ib_) * 32 + l31) * 2] = s1; MS[M_STAT + ((tb_ * 2 + ib_) * 32 + l31) * 2 + 1] = s2; }
        }
        __syncthreads();
        if (wid < 4 && c + 1 < SEQ / 64) { asm volatile("s_waitcnt vmcnt(0)" ::: "memory");
            if (lane == 0) { const unsigned old = __hip_atomic_fetch_add((LAS unsigned*)(MS + M_CNT), 1u, __ATOMIC_RELAXED, __HIP_MEMORY_SCOPE_WORKGROUP);
                if ((old & 3u) == 3u) __hip_atomic_store(flagp, (unsigned)(c + 1), RLX_AGENT); } }
        if (wid >= 4) { const int t = 32 * tb_ + l31;
            const float S1 = MS[M_STAT + ((tb_ * 2 + 0) * 32 + l31) * 2] + MS[M_STAT + ((tb_ * 2 + 1) * 32 + l31) * 2], S2 = MS[M_STAT + ((tb_ * 2 + 0) * 32 + l31) * 2 + 1] + MS[M_STAT + ((tb_ * 2 + 1) * 32 + l31) * 2 + 1];
            const float mean = S1 * (1.f / 64.f), var = fmaxf(S2 * (1.f / 64.f) - mean * mean, 0.f), rstd = 1.0f / sqrtf(var + LNX_EPS), bon = MS[M_BON + t];
            bf16* op = ORW + ((size_t)b * SEQ + 64 * c + t) * 1280 + h * 64;
#pragma unroll
            for (int q = 0; q < 4; ++q) { const int i0 = 32 * ib_ + 8 * q + 4 * hi; float o[4];
                const f32x4 gv = up4(*(const LAS unsigned long long*)(lds + O_GD + (((ib_ * 2 + tb_) * 4 + q) * 64 + lane) * 8)), vv = up4(*(const LAS unsigned long long*)(lds + O_V + boff(t, i0)));
                const f32x4 lnw = *(const LAS f32x4*)(MS + M_LNW + i0), lnb = *(const LAS f32x4*)(MS + M_LNB + i0);
#pragma unroll
                for (int e = 0; e < 4; ++e) o[e] = ((yacc[4 * q + e] - mean) * rstd * lnw[e] + lnb[e] + bon * vv[e]) * gv[e];
                *(GAS unsigned long long*)(op + i0) = pk4(o[0], o[1], o[2], o[3]); } }
        __syncthreads();
    }
#undef RW_LOAD
#undef RW_HF
}
#undef RW_ZERO16
#undef RW_MMA
}

template <int MODE>
__device__ __forceinline__ void row_pass(int lane, const float* xrow, const bf16* zrow, const float* g1, const float* g2, bf16* hrow, const bf16* z2row, const float* g3, float* orow) {
    const GAS f32x4* xr = (const GAS f32x4*)xrow + lane; const GAS unsigned long long* zr = (const GAS unsigned long long*)zrow + lane; const GAS f32x4* g1r = (const GAS f32x4*)g1 + lane;
    f32x4 z[4], x[4]; float s = 0.f;
#pragma unroll
    for (int j = 0; j < 4; ++j) { const unsigned long long w = zr[64 * j]; z[j] = (f32x4){__uint_as_float((unsigned)w << 16), __uint_as_float((unsigned)w & 0xffff0000u), __uint_as_float((unsigned)(w >> 32) << 16), __uint_as_float((unsigned)(w >> 32) & 0xffff0000u)};
        x[j] = xr[64 * j]; s += (z[j].x * z[j].x + z[j].y * z[j].y) + (z[j].z * z[j].z + z[j].w * z[j].w); }
    const float rs = 1.0f / sqrtf(wave_sum(s) * (1.f / D) + NORM_EPS); float s2 = 0.f;
#pragma unroll
    for (int j = 0; j < 4; ++j) { const f32x4 gg = g1r[64 * j]; x[j] = x[j] + z[j] * rs * gg; s2 += (x[j].x * x[j].x + x[j].y * x[j].y) + (x[j].z * x[j].z + x[j].w * x[j].w); }
    if (MODE == 0) { const float rs2 = 1.0f / sqrtf(wave_sum(s2) * (1.f / D) + NORM_EPS); const GAS f32x4* g2r = (const GAS f32x4*)g2 + lane;
        GAS unsigned long long* o8 = (GAS unsigned long long*)hrow + lane;
#pragma unroll
        for (int j = 0; j < 4; ++j) { const f32x4 gg = g2r[64 * j];
            o8[64 * j] = (unsigned long long)pk2(x[j].x * rs2 * gg.x, x[j].y * rs2 * gg.y) | ((unsigned long long)pk2(x[j].z * rs2 * gg.z, x[j].w * rs2 * gg.w) << 32); }
    } else { const GAS unsigned long long* z2r = (const GAS unsigned long long*)z2row + lane; const GAS f32x4* g3r = (const GAS f32x4*)g3 + lane; float s3 = 0.f;
#pragma unroll
        for (int j = 0; j < 4; ++j) { const unsigned long long w = z2r[64 * j]; z[j] = (f32x4){__uint_as_float((unsigned)w << 16), __uint_as_float((unsigned)w & 0xffff0000u), __uint_as_float((unsigned)(w >> 32) << 16), __uint_as_float((unsigned)(w >> 32) & 0xffff0000u)};
            s3 += (z[j].x * z[j].x + z[j].y * z[j].y) + (z[j].z * z[j].z + z[j].w * z[j].w); }
        const float rs3 = 1.0f / sqrtf(wave_sum(s3) * (1.f / D) + NORM_EPS); GAS f32x4* o = (GAS f32x4*)orow + lane;
#pragma unroll
        for (int j = 0; j < 4; ++j) { const f32x4 gg = g3r[64 * j]; o[64 * j] = x[j] + z[j] * rs3 * gg; } }
}

__global__ void __launch_bounds__(NWAVES * 64, 2) fwd_kernel(Args args) {
    extern __shared__ __attribute__((aligned(16))) unsigned char lds[];
    Frame F;
    F.lds = (LAS unsigned char*)lds;
    F.MISC = (volatile LAS unsigned*)(F.lds + MISC_OFF);
    F.wave = __builtin_amdgcn_readfirstlane(threadIdx.x >> 6); F.lane = lane_fresh(); F.tid = (F.wave << 6) | F.lane;
    F.G = gridDim.x; { const int bx = blockIdx.x; F.vcu = (F.G % 8 == 0) ? (bx % 8) * (F.G / 8) + bx / 8 : bx; }
    const Args& A = args;
    F.ctl = (gu32*)(args.ws + WS_CTL);
    for (int u = F.tid; u < (LDS_BYTES - LDSCTL_OFF) / 4; u += NWAVES * 64) ((LAS unsigned*)(F.lds + LDSCTL_OFF))[u] = 0u;
    __syncthreads();
    XcdBarrier bar = xcd_barrier_post((unsigned*)(F.ctl + CW_BAR), F.MISC + 8);
#define GRID_BAR() xcd_barrier(bar)
    unsigned char* ws = args.ws;
    bf16* XN = (bf16*)(ws + WS_XN); bf16* QKV = (bf16*)(ws + WS_QKV); bf16* FB = (bf16*)(ws + WS_F); bf16* GATE = (bf16*)args.out; bf16* ACAT = (bf16*)(ws + WS_ACAT);
    bf16* MERGED = (bf16*)(ws + WS_MERGED); bf16* Z = (bf16*)(ws + WS_Z); bf16* HB = (bf16*)(ws + WS_H); bf16* Z2 = (bf16*)(ws + WS_Z2);

    p0_prologue<0>(F, A);
    GRID_BAR();
    { pg8::Gemm g{XN, (const bf16*)(ws + WS_WIN), M, NIN, D}; pg8::StaticOrder S; S.init(M, NIN, F.G, (int)blockIdx.x);
      pg8::EpiProj E{QKV, FB, GATE, A.in[7], QSCALE};
      pg8::gemm_phase<pg8::EpiProj, pg8::StaticOrder, true, true>(F.lds + RING_OFF, g, S, E, F.wave); }
    GRID_BAR();
    att::attn_phase(F.lds, QKV, (const float*)(ws + WS_SMALL), (bf16*)(ws + WS_OPART), (float*)(ws + WS_LSE), (int)blockIdx.x, F.G, F.wave);
    GRID_BAR();
    F.lane = lane_fresh(); F.tid = (F.wave << 6) | F.lane;
    xs_prepass(FB, A.in[8], (bf16*)(ws + WS_XS), (int)blockIdx.x * NWAVES * 64 + F.tid, F.G * NWAVES * 64);
    att::attn_combine((const bf16*)(ws + WS_OPART), (const float*)(ws + WS_LSE), ACAT, (int)blockIdx.x * NWAVES * 64 + F.tid, F.G * NWAVES * 64);
    GRID_BAR();
    F.lane = lane_fresh(); F.tid = (F.wave << 6) | F.lane;
    p0_prologue<1>(F, A);
    __syncthreads();
    { const int nW = F.G >= 256 ? 2 : 1;
      if (nW == 2) { if ((int)blockIdx.x < 256) rw::rwkv_chain(F.lds, A, (int)blockIdx.x & 127, F.wave, (int)blockIdx.x >> 7, 2); }
      else { for (int c = (int)blockIdx.x; c < 128; c += F.G) rw::rwkv_chain(F.lds, A, c, F.wave, 0, 1); } }
    GRID_BAR();
    { int kcat = 1280; asm volatile("" : "+s"(kcat));
      const int swp = ((int)blockIdx.x >> 3) & 1;
      pg8::Gemm g{ACAT, (const bf16*)(ws + WS_WCAT), M, D, kcat, swp ? 4 : 0}; pg8::StaticOrder S; S.init(M, D, F.G, (int)blockIdx.x);
      pg8::EpiMerge2 E{MERGED, GATE + (swp ? 1024 : 0), GATE + (swp ? 0 : 1024), swp ? 16 : 4};
      pg8::gemm_phase<pg8::EpiMerge2, pg8::StaticOrder, true, true>(F.lds + RING_OFF, g, S, E, F.wave); }
    GRID_BAR();
    { pg8::Gemm g{MERGED, (const bf16*)(ws + WS_WO), M, D, D}; pg8::StaticOrder S; S.init(M, D, F.G, (int)blockIdx.x);
      pg8::EpiBf16Plain E{Z, D};
      pg8::gemm_phase<pg8::EpiBf16Plain, pg8::StaticOrder, true, true>(F.lds + RING_OFF, g, S, E, F.wave); }
    GRID_BAR();
    F.lane = lane_fresh(); F.tid = (F.wave << 6) | F.lane;
    { const int gw = F.vcu * NWAVES + F.wave, NGW = F.G * NWAVES;
      for (int m = gw; m < M; m += NGW) row_pass<0>(F.lane, A.in[0] + (size_t)m * D, Z + (size_t)m * D, A.in[3], A.in[4], XN + (size_t)m * D, nullptr, nullptr, nullptr); }
    GRID_BAR();
    { pg8::Gemm g{XN, (const bf16*)(ws + WS_W1), M, FF, D}; pg8::StaticOrder S; S.init(M, FF, F.G, (int)blockIdx.x);
      pg8::EpiRelu2 E{HB, FF};
      pg8::gemm_phase<pg8::EpiRelu2, pg8::StaticOrder, true, true>(F.lds + RING_OFF, g, S, E, F.wave); }
    GRID_BAR();
    { pg8::Gemm g{HB, (const bf16*)(ws + WS_W2), M, D, FF}; pg8::StaticOrder S; S.init(M, D, F.G, (int)blockIdx.x);
      pg8::EpiBf16Plain E{Z2, D};
      pg8::gemm_phase<pg8::EpiBf16Plain, pg8::StaticOrder, true, true>(F.lds + RING_OFF, g, S, E, F.wave); }
    GRID_BAR();
    F.lane = lane_fresh(); F.tid = (F.wave << 6) | F.lane;
    { const int gw = F.vcu * NWAVES + F.wave, NGW = F.G * NWAVES;
      for (int m = gw; m < M; m += NGW) row_pass<1>(F.lane, A.in[0] + (size_t)m * D, Z + (size_t)m * D, A.in[3], nullptr, nullptr, Z2 + (size_t)m * D, A.in[5], A.out + (size_t)m * D); }
}

extern "C" void kernel_launch(void* const* d_in, const int* in_sizes, int n_in, void* d_out, int out_size, void* d_ws, size_t ws_size, hipStream_t stream) {
    static int grid = 0;
    if (grid == 0) {
        if (n_in != NIN_T || out_size != M * D || ws_size < WS_END) { fprintf(stderr, "kernel_launch: unexpected shapes: n_in %d out %d ws %zu\n", n_in, out_size, ws_size); grid = -1; return; }
        int dev = 0, cus = 0, per_cu = 0;
        if (hipGetDevice(&dev) != hipSuccess || hipDeviceGetAttribute(&cus, hipDeviceAttributeMultiprocessorCount, dev) != hipSuccess) { grid = -1; return; }
        if (hipFuncSetAttribute((const void*)fwd_kernel, hipFuncAttributeMaxDynamicSharedMemorySize, LDS_BYTES) != hipSuccess) { fprintf(stderr, "kernel_launch: hipFuncSetAttribute failed\n"); grid = -1; return; }
        if (hipOccupancyMaxActiveBlocksPerMultiprocessor(&per_cu, (const void*)fwd_kernel, NWAVES * 64, LDS_BYTES) != hipSuccess || per_cu < 1) { fprintf(stderr, "kernel_launch: occupancy query says %d\n", per_cu); }
        (void)hipGetLastError();
        grid = cus;
    }
    if (grid < 0) return;
    if (hipMemsetAsync((char*)d_ws + WS_CTL, 0, CTL_ZERO_BYTES, stream) != hipSuccess) { fprintf(stderr, "kernel_launch: memset failed\n"); return; }
    Args a{};
    for (int i = 0; i < NIN_T; ++i) a.in[i] = (const float*)d_in[i];
    a.out = (float*)d_out; a.ws = (unsigned char*)d_ws;
    hipLaunchKernelGGL(fwd_kernel, dim3(grid), dim3(NWAVES * 64), LDS_BYTES, stream, a);
}
```

```cpp
#include <hip/hip_runtime.h>
#include <cstdio>
#include <cstdint>
#include <cmath>
__device__ __forceinline__ int lane_fresh() { int l; asm volatile("v_mbcnt_lo_u32_b32 %0, -1, 0\n\tv_mbcnt_hi_u32_b32 %0, -1, %0" : "=v"(l)); return l; }
namespace pg8 {
#define PG8_LAS __attribute__((address_space(3)))
typedef unsigned short bf16_t;
typedef short bf16x8 __attribute__((ext_vector_type(8)));
typedef float f32x4 __attribute__((ext_vector_type(4)));
typedef unsigned u32x4 __attribute__((ext_vector_type(4)));
constexpr int BM = 256, BK = 64, HALF = 128, HTB = HALF * BK * 2  , STAGE_BYTES = 8 * HTB, NXCD = 8, WGM = 8;

__host__ __device__ __forceinline__ int lds_byte(int r, int c) { const int st = (r >> 4) * 2 + (c >> 5), rr = r & 15, cc = c & 31, ob = rr * 64 + cc * 2; return st * 1024 + (ob ^ (((ob >> 9) & 1) << 5)); }
__host__ __device__ __forceinline__ void stage_rc(int b, int& R, int& C) { const int st = b / 1024, sb = b % 1024, swz = sb ^ (((sb >> 9) & 1) << 5); R = (st >> 1) * 16 + swz / 64; C = (st & 1) * 32 + (swz % 64) / 2; }
__host__ __device__ __forceinline__ int perm32(int rho) { const int n = rho >> 4, i = rho & 15; return 8 * (i >> 2) + 4 * n + (i & 3); }

struct Unit { int pm, pn; };
struct Gemm { const bf16_t* A; const bf16_t* Bt; int M, N, K; };

struct StaticOrder {
    int nM, nN, nwg, G, c;
    __host__ __device__ void init(int M, int N, int G_, int c_) { nM = M / BM; nN = N / BM; nwg = nM * nN; G = G_; c = c_; }
    __host__ __device__ bool next(int i, Unit& u) const {
        const long L = (long)i * G + c; if (L >= nwg) return false;
        int wgid = (int)L; { const int q = nwg / NXCD, r = nwg % NXCD, xcd = wgid % NXCD, off = wgid / NXCD; wgid = (xcd < r ? xcd * (q + 1) : r * (q + 1) + (xcd - r) * q) + off; }
        const int nig = WGM * nN, gid = wgid / nig, fm = gid * WGM, gsz = (nM - fm) < WGM ? (nM - fm) : WGM;
        u.pm = fm + ((wgid % nig) % gsz); u.pn = (wgid % nig) / gsz; return true;
    }
    __device__ __forceinline__ void a_ready(const Unit&) const {}
    __device__ __forceinline__ void done(const Unit&) const {}
};

__device__ __forceinline__ unsigned cvt_pk_bf16(float lo, float hi) { unsigned r; asm volatile("v_cvt_pk_bf16_f32 %0, %1, %2" : "=v"(r) : "v"(lo), "v"(hi)); return r; }
typedef float f32x2 __attribute__((ext_vector_type(2)));
__device__ __forceinline__ float bf2f(unsigned short b) { return __uint_as_float(((unsigned)b) << 16); }
__device__ __forceinline__ float sigm_fast(float x) { return __builtin_amdgcn_rcpf(1.0f + __builtin_amdgcn_exp2f(-1.4426950408889634f * x)); }
__device__ __forceinline__ f32x4 unpack_lo4(unsigned a, unsigned b) { return (f32x4){__uint_as_float(a << 16), __uint_as_float(a & 0xffff0000u), __uint_as_float(b << 16), __uint_as_float(b & 0xffff0000u)}; }

struct EpiProj {
    static constexpr bool PERM = true, AFTER_DRAIN = false; static constexpr int MIDK = 0;
    bf16_t* QKV; bf16_t* F; bf16_t* GATE; const float* b_gate; float qscale;
    __device__ __forceinline__ void operator()(const f32x4 (&acc)[2][2][4][2], const Unit& u, int wr, int wc, int fr, int fq) const {
        const int row0 = u.pm * BM + wr * 64 + fr; const int pn = u.pn;
        if (pn >= 22) {
            const int cg = (pn - 22) * 128 + wc * 32 + 8 * fq;
            const f32x4 b00 = *(const f32x4*)(b_gate + cg), b01 = *(const f32x4*)(b_gate + cg + 4), b10 = *(const f32x4*)(b_gate + 1024 + cg), b11 = *(const f32x4*)(b_gate + 1024 + cg + 4);
#pragma unroll
            for (int ai = 0; ai < 2; ++ai)
#pragma unroll
                for (int m = 0; m < 4; ++m) { bf16_t* rowp = GATE + (size_t)(row0 + ai * HALF + m * 16) * 2048 + cg;
                    f32x4 p0 = acc[ai][0][m][0] + b00, p1 = acc[ai][0][m][1] + b01, q0 = acc[ai][1][m][0] + b10, q1 = acc[ai][1][m][1] + b11;
#pragma unroll
                    for (int e = 0; e < 4; ++e) { q0[e] = sigm_fast(q0[e]); q1[e] = sigm_fast(q1[e]); p0[e] = sigm_fast(p0[e]) * __builtin_amdgcn_rcpf(fmaxf(q0[e], 1e-8f)); p1[e] = sigm_fast(p1[e]) * __builtin_amdgcn_rcpf(fmaxf(q1[e], 1e-8f)); }
                    u32x4 w; w.x = cvt_pk_bf16(p0[0], p0[1]); w.y = cvt_pk_bf16(p0[2], p0[3]); w.z = cvt_pk_bf16(p1[0], p1[1]); w.w = cvt_pk_bf16(p1[2], p1[3]);
                    __builtin_nontemporal_store(w, (u32x4*)rowp);
                    w.x = cvt_pk_bf16(q0[0], q0[1]); w.y = cvt_pk_bf16(q0[2], q0[3]); w.z = cvt_pk_bf16(q1[0], q1[1]); w.w = cvt_pk_bf16(q1[2], q1[3]);
                    __builtin_nontemporal_store(w, (u32x4*)(rowp + 1024));
                    asm volatile("" ::: "memory"); }
            return; }
        bf16_t* base; int ldc, colt, mode;
        if (pn < 9) { base = QKV; ldc = 2304; colt = pn * 256; mode = pn < 3 ? 1 : 0; }
        else { base = F; ldc = 3328; colt = (pn - 9) * 256; mode = 0; }
        const int col0 = colt + wc * 32 + 8 * fq;
        const float sc = (mode == 1) ? qscale : 1.0f;
#pragma unroll
        for (int ai = 0; ai < 2; ++ai)
#pragma unroll
            for (int m = 0; m < 4; ++m) { bf16_t* rowp = base + (size_t)(row0 + ai * HALF + m * 16) * ldc + col0;
#pragma unroll
                for (int bj = 0; bj < 2; ++bj) { const f32x4 v0 = acc[ai][bj][m][0] * sc, v1 = acc[ai][bj][m][1] * sc;
                    u32x4 w; w.x = cvt_pk_bf16(v0[0], v0[1]); w.y = cvt_pk_bf16(v0[2], v0[3]); w.z = cvt_pk_bf16(v1[0], v1[1]); w.w = cvt_pk_bf16(v1[2], v1[3]);
                    __builtin_nontemporal_store(w, (u32x4*)(rowp + bj * HALF)); }
                asm volatile("" ::: "memory"); }
    }
};
struct EpiMerge2 {
    static constexpr bool PERM = true, AFTER_DRAIN = false; static constexpr int MIDK = 4;
    bf16_t* OUT; const bf16_t* GATE;
    __device__ __forceinline__ void mid(f32x4 (&acc)[2][2][4][2], const Unit& u, int wr, int wc, int fr, int fq) const {
        const int row0 = u.pm * BM + wr * 64 + fr, col0 = u.pn * BM + wc * 32 + 8 * fq;
#pragma unroll
        for (int ai = 0; ai < 2; ++ai) { u32x4 g[4][2];
#pragma unroll
            for (int m = 0; m < 4; ++m)
#pragma unroll
                for (int bj = 0; bj < 2; ++bj) g[m][bj] = *(const u32x4*)(GATE + (size_t)(row0 + ai * HALF + m * 16) * 2048 + col0 + bj * HALF);
#pragma unroll
            for (int m = 0; m < 4; ++m)
#pragma unroll
                for (int bj = 0; bj < 2; ++bj) { const f32x4 a0 = unpack_lo4(g[m][bj].x, g[m][bj].y), a1 = unpack_lo4(g[m][bj].z, g[m][bj].w);
#pragma unroll
                    for (int e = 0; e < 4; ++e) { acc[ai][bj][m][0][e] *= a0[e]; acc[ai][bj][m][1][e] *= a1[e]; } }
            asm volatile("" ::: "memory"); }
    }
    __device__ __forceinline__ void operator()(const f32x4 (&acc)[2][2][4][2], const Unit& u, int wr, int wc, int fr, int fq) const {
        const int row0 = u.pm * BM + wr * 64 + fr, col0 = u.pn * BM + wc * 32 + 8 * fq;
#pragma unroll
        for (int ai = 0; ai < 2; ++ai)
#pragma unroll
            for (int m = 0; m < 4; ++m) { const size_t r = (size_t)(row0 + ai * HALF + m * 16);
#pragma unroll
                for (int bj = 0; bj < 2; ++bj) { const int c = col0 + bj * HALF;
                    const u32x4 g = *(const u32x4*)(GATE + r * 2048 + 1024 + c);
                    const f32x4 v0 = acc[ai][bj][m][0] * unpack_lo4(g.x, g.y), v1 = acc[ai][bj][m][1] * unpack_lo4(g.z, g.w);
                    u32x4 w; w.x = cvt_pk_bf16(v0[0], v0[1]); w.y = cvt_pk_bf16(v0[2], v0[3]); w.z = cvt_pk_bf16(v1[0], v1[1]); w.w = cvt_pk_bf16(v1[2], v1[3]);
                    *(u32x4*)(OUT + r * 1024 + c) = w; }
                asm volatile("" ::: "memory"); }
    }
};
struct EpiRelu2 {
    static constexpr bool PERM = true, AFTER_DRAIN = false; static constexpr int MIDK = 0;
    bf16_t* O; int ldc;
    __device__ __forceinline__ void operator()(const f32x4 (&acc)[2][2][4][2], const Unit& u, int wr, int wc, int fr, int fq) const {
        const int row0 = u.pm * BM + wr * 64 + fr, col0 = u.pn * BM + wc * 32 + 8 * fq;
#pragma unroll
        for (int ai = 0; ai < 2; ++ai)
#pragma unroll
            for (int m = 0; m < 4; ++m) { bf16_t* rowp = O + (size_t)(row0 + ai * HALF + m * 16) * ldc + col0;
#pragma unroll
                for (int bj = 0; bj < 2; ++bj) { f32x4 v0 = acc[ai][bj][m][0], v1 = acc[ai][bj][m][1];
#pragma unroll
                    for (int e = 0; e < 4; ++e) { const float a = fmaxf(v0[e], 0.f), b = fmaxf(v1[e], 0.f); v0[e] = a * a; v1[e] = b * b; }
                    u32x4 w; w.x = cvt_pk_bf16(v0[0], v0[1]); w.y = cvt_pk_bf16(v0[2], v0[3]); w.z = cvt_pk_bf16(v1[0], v1[1]); w.w = cvt_pk_bf16(v1[2], v1[3]);
                    __builtin_nontemporal_store(w, (u32x4*)(rowp + bj * HALF)); } }
    }
};
struct EpiBf16Plain {
    static constexpr bool PERM = true, AFTER_DRAIN = false; static constexpr int MIDK = 0;
    bf16_t* O; int ldc;
    __device__ __forceinline__ void operator()(const f32x4 (&acc)[2][2][4][2], const Unit& u, int wr, int wc, int fr, int fq) const {
        const int row0 = u.pm * BM + wr * 64 + fr, col0 = u.pn * BM + wc * 32 + 8 * fq;
#pragma unroll
        for (int ai = 0; ai < 2; ++ai)
#pragma unroll
            for (int m = 0; m < 4; ++m) { bf16_t* rowp = O + (size_t)(row0 + ai * HALF + m * 16) * ldc + col0;
#pragma unroll
                for (int bj = 0; bj < 2; ++bj) { const f32x4 v0 = acc[ai][bj][m][0], v1 = acc[ai][bj][m][1];
                    u32x4 w; w.x = cvt_pk_bf16(v0[0], v0[1]); w.y = cvt_pk_bf16(v0[2], v0[3]); w.z = cvt_pk_bf16(v1[0], v1[1]); w.w = cvt_pk_bf16(v1[2], v1[3]);
                    __builtin_nontemporal_store(w, (u32x4*)(rowp + bj * HALF)); } }
    }
};
template <class Epi, class Sched, bool ALIGN_EPI = false, bool SP2 = false>
__device__ __forceinline__ void gemm_phase(PG8_LAS unsigned char* lds, const Gemm g, const Sched& S, const Epi& E, int wave_) {
    const int lane = lane_fresh(), wid = wave_, tid = (wave_ << 6) | lane, wr = wid >> 2, wc = wid & 3, fr = lane & 15, fq = lane >> 4;
    const int K = g.K, nt = K / BK;
    unsigned voffA[2], voffB[2];
#pragma unroll
    for (int i = 0; i < 2; ++i) { int R, C; stage_rc(tid * 16 + i * 8192, R, C); const int Rb = Epi::PERM ? ((R & ~31) + perm32(R & 31)) : R;
        voffA[i] = (unsigned)(R * K + C) * 2u; voffB[i] = (unsigned)(Rb * K + C) * 2u; }
    const size_t kstep = (size_t)(BK * 2);
    const size_t hstep = (size_t)HALF * K * 2;
    const size_t tstep = 2 * hstep;
    const unsigned ldsw = (unsigned)wid * 1024u;
    const int aoff = lds_byte(wr * 64 + fr, fq * 8), boff = lds_byte(wc * 32 + fr, fq * 8);
#define PG8_SA(b, h) (((b) * 2 + (h)) * HTB)
#define PG8_SB(b, h) ((4 + (b) * 2 + (h)) * HTB)
#define PG8_STAGE(bufoff, gbase, voff) do { _Pragma("unroll") for (int _i = 0; _i < 2; ++_i) \
        __builtin_amdgcn_global_load_lds((const unsigned*)((const char*)(gbase) + (voff)[_i]), (PG8_LAS unsigned*)(lds + (bufoff) + ldsw + _i * 8192), 16, 0, 0); } while (0)
#define PG8_LDA(dst, b, h) do { _Pragma("unroll") for (int m = 0; m < 4; ++m) _Pragma("unroll") for (int k = 0; k < 2; ++k) dst[m][k] = *(const PG8_LAS bf16x8*)(lds + PG8_SA(b, h) + aoff + m * 2048 + k * 1024); } while (0)
#define PG8_LDB(dst, b, h) do { _Pragma("unroll") for (int n = 0; n < 2; ++n) _Pragma("unroll") for (int k = 0; k < 2; ++k) dst[n][k] = *(const PG8_LAS bf16x8*)(lds + PG8_SB(b, h) + boff + n * 2048 + k * 1024); } while (0)
#define PG8_MMA(ai, bj, At, Bt) do { __builtin_amdgcn_s_setprio(1); _Pragma("unroll") for (int m = 0; m < 4; ++m) _Pragma("unroll") for (int n = 0; n < 2; ++n) _Pragma("unroll") for (int k = 0; k < 2; ++k) \
        acc[ai][bj][m][n] = __builtin_amdgcn_mfma_f32_16x16x32_bf16(Bt[n][k], At[m][k], acc[ai][bj][m][n], 0, 0, 0); __builtin_amdgcn_s_setprio(0); } while (0)
#define PG8_WAIT_V(n) asm volatile("s_waitcnt vmcnt(" #n ")" ::: "memory")
#define PG8_WAIT_L(n) asm volatile("s_waitcnt lgkmcnt(" #n ")" ::: "memory")
#define PG8_BAR __builtin_amdgcn_s_barrier()
#define PG8_SCHED __builtin_amdgcn_sched_barrier(0)
    Unit cur, nxt; int ui = 0;
    if (!S.next(0, cur)) return;
    f32x4 acc[2][2][4][2];
#pragma unroll
    for (int a = 0; a < 2; ++a)
#pragma unroll
        for (int b = 0; b < 2; ++b)
#pragma unroll
            for (int m = 0; m < 4; ++m)
#pragma unroll
                for (int n = 0; n < 2; ++n) acc[a][b][m][n] = (f32x4){0.f, 0.f, 0.f, 0.f};
    bf16x8 At[4][2], B0[2][2], B1[2][2];
    const char* cA = (const char*)g.A + (size_t)cur.pm * tstep; const char* cB = (const char*)g.Bt + (size_t)cur.pn * tstep;
    S.a_ready(cur);
    if constexpr (SP2) {
        PG8_STAGE(PG8_SB(0, 0), cB, voffB); PG8_STAGE(PG8_SB(0, 1), cB + hstep, voffB); PG8_STAGE(PG8_SA(0, 0), cA, voffA); PG8_STAGE(PG8_SA(0, 1), cA + hstep, voffA);
        if (wr == 1) PG8_BAR;
        PG8_WAIT_V(2); PG8_BAR;
        PG8_STAGE(PG8_SB(1, 0), cB + kstep, voffB); PG8_STAGE(PG8_SA(1, 0), cA + kstep, voffA); PG8_STAGE(PG8_SB(1, 1), cB + hstep + kstep, voffB);
        PG8_WAIT_V(6); PG8_BAR;
    } else {
        PG8_STAGE(PG8_SB(0, 0), cB, voffB); PG8_STAGE(PG8_SA(0, 0), cA, voffA); PG8_STAGE(PG8_SB(0, 1), cB + hstep, voffB); PG8_STAGE(PG8_SA(0, 1), cA + hstep, voffA);
        if (wr == 1) PG8_BAR;
        PG8_WAIT_V(4); PG8_BAR;
        PG8_STAGE(PG8_SB(1, 0), cB + kstep, voffB); PG8_STAGE(PG8_SA(1, 0), cA + kstep, voffA); PG8_STAGE(PG8_SB(1, 1), cB + hstep + kstep, voffB);
        PG8_WAIT_V(6); PG8_BAR;
    }
    for (;;) {
        const bool has_next = S.next(ui + 1, nxt);
        const char* nA = has_next ? (const char*)g.A + (size_t)nxt.pm * tstep : cA; const char* nB = has_next ? (const char*)g.Bt + (size_t)nxt.pn * tstep : cB;
        asm volatile(".p2align 8");
        for (int t = 0; t < nt; t += 2) {
            if constexpr (Epi::MIDK > 0) { if (t == Epi::MIDK) E.mid(acc, cur, wr, wc, fr, fq); }
            const bool last = (t == nt - 2);
            const char* a1 = cA + (size_t)(t + 1) * kstep;
            const char* a2 = last ? nA : cA + (size_t)(t + 2) * kstep; const char* b2 = last ? nB : cB + (size_t)(t + 2) * kstep;
            const char* a3 = a2 + kstep; const char* b3 = b2 + kstep;
            if (last && has_next) S.a_ready(nxt);
            if constexpr (SP2) {
            PG8_LDB(B0, 0, 0); PG8_LDB(B1, 0, 1); PG8_SCHED; PG8_LDA(At, 0, 0); PG8_STAGE(PG8_SA(1, 1), a1 + hstep, voffA);
            PG8_WAIT_V(8); PG8_WAIT_L(0); PG8_BAR; PG8_MMA(0, 0, At, B0); PG8_MMA(0, 1, At, B1); PG8_BAR; PG8_SCHED;
            PG8_LDA(At, 0, 1); PG8_STAGE(PG8_SB(0, 0), b2, voffB); PG8_STAGE(PG8_SB(0, 1), b2 + hstep, voffB); PG8_STAGE(PG8_SA(0, 0), a2, voffA);
            PG8_WAIT_V(8); PG8_WAIT_L(0); PG8_BAR; PG8_MMA(1, 0, At, B0); PG8_MMA(1, 1, At, B1); PG8_BAR; PG8_SCHED;
            PG8_LDB(B0, 1, 0); PG8_LDB(B1, 1, 1); PG8_SCHED; PG8_LDA(At, 1, 0); PG8_STAGE(PG8_SA(0, 1), a2 + hstep, voffA);
            PG8_WAIT_V(8); PG8_WAIT_L(0); PG8_BAR; PG8_MMA(0, 0, At, B0); PG8_MMA(0, 1, At, B1); PG8_BAR; PG8_SCHED;
            PG8_LDA(At, 1, 1); PG8_STAGE(PG8_SB(1, 0), b3, voffB); PG8_STAGE(PG8_SB(1, 1), b3 + hstep, voffB); PG8_STAGE(PG8_SA(1, 0), a3, voffA);
            PG8_WAIT_V(8); PG8_WAIT_L(0); PG8_BAR; PG8_MMA(1, 0, At, B0); PG8_MMA(1, 1, At, B1); PG8_BAR; PG8_SCHED;
            } else {
            PG8_LDB(B0, 0, 0); PG8_SCHED; PG8_LDA(At, 0, 0); PG8_STAGE(PG8_SA(1, 1), a1 + hstep, voffA);
            PG8_WAIT_L(8); PG8_BAR; PG8_WAIT_L(0); PG8_MMA(0, 0, At, B0); PG8_BAR; PG8_SCHED;
            PG8_LDB(B1, 0, 1); PG8_STAGE(PG8_SB(0, 0), b2, voffB);
            PG8_BAR; PG8_WAIT_L(0); PG8_MMA(0, 1, At, B1); PG8_BAR;
            PG8_LDA(At, 0, 1); PG8_STAGE(PG8_SA(0, 0), a2, voffA);
            PG8_BAR; PG8_WAIT_L(0); PG8_MMA(1, 0, At, B0); PG8_BAR; PG8_SCHED;
            PG8_STAGE(PG8_SB(0, 1), b2 + hstep, voffB);
            PG8_WAIT_V(6); PG8_BAR; PG8_MMA(1, 1, At, B1); PG8_BAR;
            PG8_LDB(B0, 1, 0); PG8_SCHED; PG8_LDA(At, 1, 0); PG8_STAGE(PG8_SA(0, 1), a2 + hstep, voffA);
            PG8_WAIT_L(8); PG8_BAR; PG8_WAIT_L(0); PG8_MMA(0, 0, At, B0); PG8_BAR; PG8_SCHED;
            PG8_LDB(B1, 1, 1); PG8_STAGE(PG8_SB(1, 0), b3, voffB);
            PG8_BAR; PG8_WAIT_L(0); PG8_MMA(0, 1, At, B1); PG8_BAR;
            PG8_LDA(At, 1, 1); PG8_STAGE(PG8_SA(1, 0), a3, voffA);
            PG8_BAR; PG8_WAIT_L(0); PG8_MMA(1, 0, At, B0); PG8_BAR; PG8_SCHED;
            PG8_STAGE(PG8_SB(1, 1), b3 + hstep, voffB);
            PG8_WAIT_V(6); PG8_BAR; PG8_MMA(1, 1, At, B1); PG8_BAR;
            }
        }
        if constexpr (ALIGN_EPI) { if (wr == 0) PG8_BAR; }
        if constexpr (!Epi::AFTER_DRAIN) { E(acc, cur, wr, wc, fr, fq); S.done(cur); }
        if (!has_next) break;
#pragma unroll
        for (int a = 0; a < 2; ++a)
#pragma unroll
            for (int b = 0; b < 2; ++b)
#pragma unroll
                for (int m = 0; m < 4; ++m)
#pragma unroll
                    for (int n = 0; n < 2; ++n) acc[a][b][m][n] = (f32x4){0.f, 0.f, 0.f, 0.f};
        cur = nxt; cA = nA; cB = nB; ++ui;
        if constexpr (ALIGN_EPI) { if (wr == 1) PG8_BAR; }
    }
    PG8_WAIT_V(0);
    if constexpr (!ALIGN_EPI) { if (wr == 0) PG8_BAR; }
    PG8_BAR;
    if constexpr (Epi::AFTER_DRAIN) { E.fused(acc, cur, wr, wc, fr, fq, lds, wid, lane); S.done(cur); }
#undef PG8_SA
#undef PG8_SB
#undef PG8_STAGE
#undef PG8_LDA
#undef PG8_LDB
#undef PG8_MMA
#undef PG8_WAIT_V
#undef PG8_WAIT_L
#undef PG8_BAR
#undef PG8_SCHED
}
}
constexpr int NWAVES = 8;
constexpr int BATCH = 8, SEQ = 4096, D = 1024, M = BATCH * SEQ;
constexpr int NQKV = 2304, NF = 3328, NG = 2048, NIN = 7680, FF = 4096, AO = 256;
constexpr float NORM_EPS = 1e-6f, LNX_EPS = 64e-5f, LOG2E = 1.4426950408889634f;
constexpr float QSCALE = 0.125f * LOG2E;
constexpr int NIN_T = 24;
constexpr size_t KiB = 1024, MiB = 1u << 20;
constexpr size_t WS_CTL = 0, CTL_ZERO_BYTES = 1 * MiB;
constexpr size_t WS_SMALL = 1 * MiB;
constexpr size_t WS_LORA = 1 * MiB + 64 * KiB;
constexpr size_t WS_WCAT = 2 * MiB;
constexpr size_t WS_WO = 4 * MiB + 512 * KiB;
constexpr size_t WS_W1 = 6 * MiB + 512 * KiB;
constexpr size_t WS_W2 = 14 * MiB + 512 * KiB;
constexpr size_t WS_WIN = 24 * MiB;
constexpr size_t WS_ACAT = 24 * MiB;
constexpr size_t WS_XS = 104 * MiB;
constexpr size_t WS_XN = 40 * MiB;
constexpr size_t WS_QKV = 104 * MiB;
constexpr size_t WS_F = 248 * MiB;
constexpr size_t WS_OPART = 456 * MiB;
constexpr size_t WS_LSE = 504 * MiB;
constexpr size_t WS_MERGED = WS_F;
constexpr size_t WS_Z = 424 * MiB;
constexpr size_t WS_H = 104 * MiB;
constexpr size_t WS_Z2 = 360 * MiB;
constexpr size_t WS_END = 512 * MiB;
static_assert(WS_Z + (size_t)M * D * 2 <= WS_END && WS_H + (size_t)M * FF * 2 <= WS_Z2 && WS_Z2 + (size_t)M * D * 2 <= WS_Z && WS_LSE + (size_t)3 * M * 4 * 4 <= WS_END
              && WS_W2 + (size_t)D * FF * 2 <= WS_WIN && WS_WIN + (size_t)NIN * D * 2 <= WS_XN && WS_ACAT + (size_t)M * 1280 * 2 <= WS_QKV && WS_WCAT + (size_t)D * 1280 * 2 <= WS_WO && WS_MERGED + (size_t)M * D * 2 <= WS_Z2, "ws map");
constexpr int CW_BAR = 4096;
constexpr int CW_RWF = 16384;
constexpr size_t WS_HX = 506 * MiB;
constexpr int RING_OFF = 0, RING_BYTES = 131072;
constexpr int LDSCTL_OFF = RING_BYTES, MISC_OFF = LDSCTL_OFF + 320;
constexpr int VEC_OFF = RING_BYTES + 1024;
constexpr int LDS_BYTES = 147456;

#define GAS __attribute__((address_space(1)))
#define LAS __attribute__((address_space(3)))
typedef unsigned short bf16;
typedef unsigned v4u __attribute__((ext_vector_type(4)));
typedef float f32x4 __attribute__((ext_vector_type(4)));
typedef short bf16x8 __attribute__((ext_vector_type(8)));
typedef GAS unsigned gu32;
typedef GAS unsigned long long gu64;
#define RLX_AGENT __ATOMIC_RELAXED, __HIP_MEMORY_SCOPE_AGENT
#define LDS_WAIT() asm volatile("s_waitcnt lgkmcnt(0)" ::: "memory")
#define VM_WAIT() asm volatile("s_waitcnt vmcnt(0)" ::: "memory")
__device__ __forceinline__ unsigned long long rt() { return __builtin_amdgcn_s_memrealtime(); }
__device__ __forceinline__ unsigned f2bf(float f) { unsigned u = __builtin_bit_cast(unsigned, f); return (u + 0x7fffu + ((u >> 16) & 1u)) >> 16; }
typedef float f32x2_t __attribute__((ext_vector_type(2))); typedef __bf16 bf16x2_t __attribute__((ext_vector_type(2)));
__device__ __forceinline__ unsigned pk2(float lo, float hi) { f32x2_t v = {lo, hi}; bf16x2_t b = __builtin_convertvector(v, bf16x2_t); return __builtin_bit_cast(unsigned, b); }

#define XB_TMO      128
#define XB_XCNT(j)  (256  + 64 * (j))
#define XB_XSUB(j)  (1280 + 64 * (j))
#define XB_XGEN(j)  (2304 + 64 * (j))
#define XB_TOP      3328
#define XB_TOPGEN   3392
#define XCD_BAR_WORDS 3456
#define XB_SPIN_CAP (1u << 18)

__device__ __forceinline__ unsigned xb_ld(unsigned* p)              { return __hip_atomic_load(p, __ATOMIC_RELAXED, __HIP_MEMORY_SCOPE_AGENT); }
__device__ __forceinline__ unsigned xb_add(unsigned* p, unsigned v) { return __hip_atomic_fetch_add(p, v, __ATOMIC_RELAXED, __HIP_MEMORY_SCOPE_AGENT); }
__device__ __forceinline__ unsigned xb_xcc_id() { return (unsigned)__builtin_amdgcn_s_getreg((3 << 11) | 20) & 0xFu; }
#define XB_SPIN(cond, bar) do { unsigned _sp = 0; while (cond) { __builtin_amdgcn_s_sleep(1); \
    if ((++_sp & 255u) == 0u) { if (xb_ld(&(bar)[XB_TMO])) break; if (_sp > XB_SPIN_CAP) { atomicAdd(&(bar)[XB_TMO], 1u); break; } } } } while (0)

struct XcdBarrier {
    unsigned* bar; unsigned x;
    volatile LAS unsigned* st;
};

__device__ __forceinline__ XcdBarrier xcd_barrier_post(unsigned* bar, volatile LAS unsigned* st) {
    XcdBarrier b; b.bar = bar; b.x = xb_xcc_id(); b.st = st;
    if (threadIdx.x == 0) (void)xb_add(&bar[XB_XCNT(b.x)], 1u);
    return b;
}
__device__ __forceinline__ void xcd_barrier_complete(unsigned* bar, unsigned x, unsigned& nloc, unsigned& nx) {
    const unsigned G = gridDim.x * gridDim.y * gridDim.z;
    unsigned sum, cnt, mine, sp = 0u;
    for (;;) {
        sum = 0u; cnt = 0u; mine = 0u;
#pragma unroll
        for (unsigned j = 0; j < 16; ++j) { const unsigned c = xb_ld(&bar[XB_XCNT(j)]); sum += c; cnt += (c > 0u) ? 1u : 0u; mine = (j == x) ? c : mine; }
        if (sum == G) break;
        __builtin_amdgcn_s_sleep(1);
        if ((++sp & 255u) == 0u) { if (xb_ld(&bar[XB_TMO])) break; if (sp > XB_SPIN_CAP) { atomicAdd(&bar[XB_TMO], 1u); break; } }
    }
    nloc = mine > 0u ? mine : 1u; nx = cnt > 0u ? cnt : 1u;
}

__device__ __forceinline__ void xcd_barrier(const XcdBarrier& b) {
    asm volatile("s_waitcnt vmcnt(0)" ::: "memory");
    __syncthreads();
    if (threadIdx.x == 0) {
        unsigned* bar = b.bar;
        __builtin_amdgcn_s_waitcnt(0);
        unsigned nloc = b.st[0], nx = b.st[1];
        if (nloc == 0u) { xcd_barrier_complete(bar, b.x, nloc, nx); b.st[0] = nloc; b.st[1] = nx; }
        const unsigned old = xb_add(&bar[XB_XSUB(b.x)], 1u);
        const unsigned gen = old / nloc;
        if (old + 1u == (gen + 1u) * nloc) {
            __builtin_amdgcn_fence(__ATOMIC_RELEASE, "agent");
            asm volatile("s_waitcnt vmcnt(0)" ::: "memory");
            const unsigned og = xb_add(&bar[XB_TOP], 1u);
            const unsigned tg = og / nx;
            if (og + 1u == (tg + 1u) * nx) xb_add(&bar[XB_TOPGEN], 1u);
            else XB_SPIN(xb_ld(&bar[XB_TOPGEN]) == tg, bar);
            __builtin_amdgcn_fence(__ATOMIC_ACQUIRE, "agent");
            xb_add(&bar[XB_XGEN(b.x)], 1u);
            asm volatile("s_waitcnt vmcnt(0)" ::: "memory");
        } else {
            XB_SPIN(xb_ld(&bar[XB_XGEN(b.x)]) == gen, bar);
            __builtin_amdgcn_fence(__ATOMIC_ACQUIRE, "agent");
            asm volatile("s_waitcnt vmcnt(0)" ::: "memory");
        }
    }
    __syncthreads();
}
struct Frame {
    LAS unsigned char* lds;
    volatile LAS unsigned* MISC;
    gu32* ctl;
    int tid, lane, wave;
    int vcu, G;
};
struct Args { const float* in[NIN_T]; float* out; unsigned char* ws; };
__device__ __forceinline__ float wave_sum(float v) {
#pragma unroll
    for (int o = 1; o < 64; o <<= 1) v += __shfl_xor(v, o);
    return v;
}
__device__ __forceinline__ float wave_max(float v) {
#pragma unroll
    for (int o = 1; o < 64; o <<= 1) v = fmaxf(v, __shfl_xor(v, o));
    return v;
}
__device__ __forceinline__ float bf2f(unsigned short b) { return __uint_as_float(((unsigned)b) << 16); }
__device__ __forceinline__ unsigned short f2bf16(float f) { return (unsigned short)(pk2(f, 0.f) & 0xffffu); }

struct TrItem { const float* W; bf16* WT; int K, N, ldw, koff, item; int gperm = 0; };
__device__ __forceinline__ void tr_load(const TrItem& it, int lane, f32x4 (&v)[8]) {
    const int nblk = it.N / 32, kb = it.item / nblk, nb = it.item % nblk, k0 = 64 * kb, n0 = 32 * nb;
#pragma unroll
    for (int i = 0; i < 8; ++i) { const int kk = 8 * i + (lane >> 3), nn = 4 * (lane & 7); v[i] = *(const GAS f32x4*)(it.W + (size_t)(k0 + kk) * it.N + n0 + nn); }
}
__device__ __forceinline__ void tr_finish(const TrItem& it, int lane, const f32x4 (&v)[8], LAS float* scr) {
    const int nblk = it.N / 32, kb = it.item / nblk, nb = it.item % nblk, k0 = 64 * kb, n0 = 32 * nb;
#pragma unroll
    for (int i = 0; i < 8; ++i) { const int kk = 8 * i + (lane >> 3), nn = 4 * (lane & 7); scr[kk * 33 + nn] = v[i].x; scr[kk * 33 + nn + 1] = v[i].y; scr[kk * 33 + nn + 2] = v[i].z; scr[kk * 33 + nn + 3] = v[i].w; }
    LDS_WAIT(); asm volatile("" ::: "memory");
    const int c = lane & 7; int nd = n0;
    if (it.gperm && n0 >= 5632) { const int l = (n0 - 5632) >> 5, pl = l >> 5, l2 = l & 31; nd = 5632 + 256 * (l2 >> 2) + 128 * pl + 32 * (l2 & 3); }
#pragma unroll
    for (int j = 0; j < 4; ++j) { const int n = (lane >> 3) + 8 * j; const LAS float* s = scr + (8 * c) * 33 + n;
        v4u o; o.x = pk2(s[0 * 33], s[1 * 33]); o.y = pk2(s[2 * 33], s[3 * 33]); o.z = pk2(s[4 * 33], s[5 * 33]); o.w = pk2(s[6 * 33], s[7 * 33]);
        *(GAS v4u*)(it.WT + (size_t)(nd + n) * it.ldw + it.koff + k0 + 8 * c) = o; }
    LDS_WAIT(); asm volatile("" ::: "memory");
}
template <int NR>
__device__ __forceinline__ void rms_rows_to_bf16(int lane, const float* xrow, size_t rstride, const float* g, bf16* orow) {
    const GAS f32x4* gr = (const GAS f32x4*)g + lane;
    f32x4 v[NR][4]; float s[NR];
#pragma unroll
    for (int r = 0; r < NR; ++r) { const GAS f32x4* xr = (const GAS f32x4*)(xrow + r * rstride) + lane;
#pragma unroll
        for (int j = 0; j < 4; ++j) v[r][j] = xr[64 * j]; }
#pragma unroll
    for (int r = 0; r < NR; ++r) { s[r] = 0.f;
#pragma unroll
        for (int j = 0; j < 4; ++j) s[r] += (v[r][j].x * v[r][j].x + v[r][j].y * v[r][j].y) + (v[r][j].z * v[r][j].z + v[r][j].w * v[r][j].w); }
#pragma unroll
    for (int r = 0; r < NR; ++r) { const float rs = 1.0f / sqrtf(wave_sum(s[r]) * (1.f / D) + NORM_EPS);
        GAS unsigned long long* o8 = (GAS unsigned long long*)(orow + r * rstride) + lane;
#pragma unroll
        for (int j = 0; j < 4; ++j) { const f32x4 gg = gr[64 * j];
            o8[64 * j] = (unsigned long long)pk2(v[r][j].x * rs * gg.x, v[r][j].y * rs * gg.y) | ((unsigned long long)pk2(v[r][j].z * rs * gg.z, v[r][j].w * rs * gg.w) << 32); } }
}
template <int PART>
__device__ __forceinline__ void p0_prologue(Frame& F, const Args& A) {
    LAS float* scr = (LAS float*)(F.lds + RING_OFF + F.wave * 16384);
    const int gw = F.vcu * NWAVES + F.wave, NGW = F.G * NWAVES;
    bf16* WinT = (bf16*)(A.ws + WS_WIN); bf16* WcT = (bf16*)(A.ws + WS_WCAT); bf16* WoT = (bf16*)(A.ws + WS_WO);
    bf16* W1T = (bf16*)(A.ws + WS_W1); bf16* W2T = (bf16*)(A.ws + WS_W2);
    constexpr int I_IN = (D / 64) * (NIN / 32), I_A = (AO / 64) * (D / 32), I_R = (D / 64) * (D / 32), I_O = I_R, I_1 = (D / 64) * (FF / 32), I_2 = (FF / 64) * (D / 32);
    constexpr int NITEMS = I_IN + I_A + I_R + I_O + I_1 + I_2;
    auto mk = [&](int it) { TrItem t; int r = it;
        if (r < I_IN) { t = TrItem{A.in[6], WinT, D, NIN, D, 0, r, 1}; return t; } r -= I_IN;
        if (r < I_A) { t = TrItem{A.in[19], WcT, AO, D, 1280, 0, r}; return t; } r -= I_A;
        if (r < I_R) { t = TrItem{A.in[20], WcT, D, D, 1280, 256, r}; return t; } r -= I_R;
        if (r < I_O) { t = TrItem{A.in[21], WoT, D, D, D, 0, r}; return t; } r -= I_O;
        if (r < I_1) { t = TrItem{A.in[22], W1T, D, FF, D, 0, r}; return t; } r -= I_1;
        t = TrItem{A.in[23], W2T, FF, D, FF, 0, r}; return t; };
    { constexpr int LO = PART == 0 ? 0 : I_IN, HI = PART == 0 ? I_IN : NITEMS;
      f32x4 va[8], vb[8]; int it = LO + gw;
      if (it < HI) { tr_load(mk(it), F.lane, va); }
      for (; it < HI; it += 2 * NGW) {
          if (it + NGW < HI) tr_load(mk(it + NGW), F.lane, vb);
          tr_finish(mk(it), F.lane, va, scr);
          if (it + 2 * NGW < HI) tr_load(mk(it + 2 * NGW), F.lane, va);
          if (it + NGW < HI) tr_finish(mk(it + NGW), F.lane, vb, scr); } }
    if (PART == 1) return;
    bf16* XN = (bf16*)(A.ws + WS_XN);
    for (int m = 2 * gw; m < M; m += 2 * NGW) rms_rows_to_bf16<2>(F.lane, A.in[0] + (size_t)m * D, D, A.in[2], XN + (size_t)m * D);
    { bf16* WwT = (bf16*)(A.ws + WS_LORA); bf16* WaT = (bf16*)(A.ws + WS_LORA + 131072); bf16* WgT = (bf16*)(A.ws + WS_LORA + 262144);
      const int gt = F.vcu * NWAVES * 64 + F.tid, NT = F.G * NWAVES * 64;
      for (int idx = gt; idx < 65536; idx += NT) { const int hh = idx >> 12, c = (idx >> 6) & 63, m = idx & 63; WwT[idx] = f2bf16(A.in[10][(size_t)m * 1024 + hh * 64 + c]); WaT[idx] = f2bf16(A.in[12][(size_t)m * 1024 + hh * 64 + c]); }
      for (int idx = gt; idx < 131072; idx += NT) { const int hh = idx >> 13, c = (idx >> 7) & 63, m = idx & 127; WgT[idx] = f2bf16(A.in[13][(size_t)m * 1024 + hh * 64 + c]); } }
    if (blockIdx.x == 0) {
        float* bt = (float*)(A.ws + WS_SMALL);
        for (int idx = F.tid; idx < 3 * 4 * 129; idx += NWAVES * 64) {
            const int g = idx / (4 * 129), hh = (idx / 129) % 4, j = idx % 129; const int dist = j << (2 * g);
            int bucket;
            if (dist < 16) bucket = dist;
            else { const float df = (float)dist; int large = 16 + (int)(logf(df / 16.0f) / 4.852030263919617f * 16.0f); bucket = large < 31 ? large : 31; }
            bt[idx] = A.in[1][bucket * 12 + g * 4 + hh] * LOG2E;
        }
    }
}

namespace att {
typedef short v4i16 __attribute__((ext_vector_type(4)));
typedef float f32x16 __attribute__((ext_vector_type(16)));
typedef short s16x8 __attribute__((ext_vector_type(8)));
constexpr int K_OFF = 0, V_OFF = 49152, REV_OFF = 98304, WSF_OFF = 99328, OST_OFF = 100352, LDS_USED = 100352 + 16384;
static_assert(LDS_USED <= RING_BYTES, "attention LDS map");
constexpr int NUNITS = BATCH * 4 * 48;
__device__ __forceinline__ int crow(int r, int hi) { return (r & 3) + 8 * (r >> 2) + 4 * hi; }
__device__ __forceinline__ v4i16 vtr(const LAS unsigned char* p) { return __builtin_amdgcn_ds_read_tr16_b64_v4i16((LAS v4i16*)p); }
struct UnitDesc { int b, hh, g, dsh, r, blk, S0, head; };
__device__ __forceinline__ UnitDesc decode_unit(int u) { UnitDesc d; d.b = u / 192; const int rem = u % 192; d.hh = rem / 48; const int x = rem % 48; d.g = x >> 4; const int y = x & 15;
    d.dsh = 2 * d.g; d.r = (d.g == 0) ? 0 : (d.g == 1 ? (y >> 2) : y); d.blk = (d.g == 0) ? y : (d.g == 1 ? (y & 3) : 0); d.S0 = d.blk * 256; d.head = d.g * 4 + d.hh; return d; }
__device__ __forceinline__ void attn_phase(LAS unsigned char* lds, const bf16* QKV, const float* bias2, bf16* OPART, float* LSE, int u0, int ustep, int wave_) {
    const int lane = lane_fresh(), tid = (wave_ << 6) | lane, l31 = lane & 31, hi = lane >> 5, wid = wave_;
    LAS float* REV = (LAS float*)(lds + REV_OFF); LAS float* WSF = (LAS float*)(lds + WSF_OFF);
    v4u kr[6], vr[6]; s16x8 qr[4]; float rvp = -INFINITY;
#define ATT_LOAD(uu) do { const UnitDesc d_ = decode_unit(uu); const size_t rb_ = (size_t)d_.b * SEQ; \
        _Pragma("unroll") for (int c = 0; c < 6; ++c) { const int idx = tid + 512 * c, row = idx >> 3, ch = idx & 7; int s_ = d_.S0 - 128 + row; s_ = s_ < 0 ? 0 : s_; const int t_ = (s_ << d_.dsh) + d_.r; \
            const bf16* gp = QKV + (rb_ + t_) * NQKV + 768 + d_.head * 64 + ch * 8; kr[c] = *(const GAS v4u*)gp; vr[c] = *(const GAS v4u*)(gp + 768); } \
        { const int t_ = ((d_.S0 + 32 * wid + l31) << d_.dsh) + d_.r; const bf16* qp = QKV + (rb_ + t_) * NQKV + d_.head * 64 + 8 * hi; \
          _Pragma("unroll") for (int ks = 0; ks < 4; ++ks) qr[ks] = *(const GAS s16x8*)(qp + 16 * ks); } \
        { const int uu_ = tid - 32; rvp = -INFINITY; if (tid < 224 && uu_ >= 0 && uu_ <= 128) rvp = bias2[(d_.g * 4 + d_.hh) * 129 + 128 - uu_]; } } while (0)
    if (u0 < NUNITS) ATT_LOAD(u0);
    for (int u = u0; u < NUNITS; u += ustep) {
        const UnitDesc d = decode_unit(u); const int b = d.b, hh = d.hh, g = d.g, dsh = d.dsh, r = d.r, blk = d.blk, S0 = d.S0;
        const size_t rowbase = (size_t)b * SEQ;
        if (tid < 224) REV[tid] = rvp;
#pragma unroll
        for (int c = 0; c < 6; ++c) { const int idx = tid + 512 * c, row = idx >> 3, ch = idx & 7; const int off = row * 128 + ((ch ^ (row & 7)) << 4);
            *(LAS v4u*)(lds + K_OFF + off) = kr[c]; *(LAS v4u*)(lds + V_OFF + off) = vr[c]; }
        s16x8 qc[4];
#pragma unroll
        for (int ks = 0; ks < 4; ++ks) qc[ks] = qr[ks];
        __syncthreads();
        if (u + ustep < NUNITS) ATT_LOAD(u + ustep);
        f32x16 p[5];
#pragma unroll
        for (int kt = 0; kt < 5; ++kt) {
            const int rowk = 32 * wid + 32 * kt + l31; const LAS unsigned char* kb = lds + K_OFF + rowk * 128;
            f32x16 acc = {0.f, 0.f, 0.f, 0.f, 0.f, 0.f, 0.f, 0.f, 0.f, 0.f, 0.f, 0.f, 0.f, 0.f, 0.f, 0.f};
#pragma unroll
            for (int ks = 0; ks < 4; ++ks) { const s16x8 kf = *(const LAS s16x8*)(kb + (((2 * ks + hi) ^ (rowk & 7)) << 4)); acc = __builtin_amdgcn_mfma_f32_32x32x16_bf16(kf, qc[ks], acc, 0, 0, 0); }
            const LAS float* rv = REV + 32 + 32 * kt + 4 * hi - l31;
            const float deadv = ((blk == 0) && (wid + kt < 4)) ? -INFINITY : 0.f;
#pragma unroll
            for (int rg = 0; rg < 16; ++rg) { const float bv = rv[(rg & 3) + 8 * (rg >> 2)]; acc[rg] = (acc[rg] + bv) + deadv; }
            p[kt] = acc;
        }
        float m = p[0][0];
#pragma unroll
        for (int kt = 0; kt < 5; ++kt)
#pragma unroll
            for (int rg = 0; rg < 16; ++rg) m = fmaxf(m, p[kt][rg]);
        m = fmaxf(m, __shfl_xor(m, 32));
        float l = 0.f;
#pragma unroll
        for (int kt = 0; kt < 5; ++kt)
#pragma unroll
            for (int rg = 0; rg < 16; ++rg) { const float e = __builtin_amdgcn_exp2f(p[kt][rg] - m); p[kt][rg] = e; l += e; }
        l += __shfl_xor(l, 32);
        if (hi == 0) { WSF[wid * 32 + l31] = l; const int t = ((S0 + 32 * wid + l31) << dsh) + r; LSE[((size_t)g * M + rowbase + t) * 4 + hh] = m + __builtin_amdgcn_logf(l); }
        f32x16 z[2];
#pragma unroll
        for (int db = 0; db < 2; ++db) z[db] = (f32x16){0.f, 0.f, 0.f, 0.f, 0.f, 0.f, 0.f, 0.f, 0.f, 0.f, 0.f, 0.f, 0.f, 0.f, 0.f, 0.f};
        const int q4 = (lane & 15) >> 2, c2 = 2 * ((lane >> 4) & 1) + ((lane & 3) >> 1), sw = 4 * hi + q4;
#pragma unroll
        for (int kt = 0; kt < 5; ++kt)
#pragma unroll
            for (int s = 0; s < 2; ++s) {
                s16x8 pa;
#pragma unroll
                for (int e = 0; e < 4; ++e) { const unsigned w = pk2(p[kt][8 * s + 2 * e], p[kt][8 * s + 2 * e + 1]); pa[2 * e] = (short)(w & 0xffffu); pa[2 * e + 1] = (short)(w >> 16); }
                const int vrow = 32 * wid + 32 * kt + 16 * s + 4 * hi + q4;
#pragma unroll
                for (int db = 0; db < 2; ++db) {
                    const LAS unsigned char* vp = lds + V_OFF + vrow * 128 + (((4 * db + c2) ^ sw) << 4) + 8 * (lane & 1);
                    const v4i16 lo = vtr(vp), hi4 = vtr(vp + 8 * 128);
                    const s16x8 vf = (s16x8){lo[0], lo[1], lo[2], lo[3], hi4[0], hi4[1], hi4[2], hi4[3]};
                    z[db] = __builtin_amdgcn_mfma_f32_32x32x16_bf16(pa, vf, z[db], 0, 0, 0);
                }
            }
        { LAS unsigned short* stg = (LAS unsigned short*)(lds + OST_OFF) + wid * 1024;
#pragma unroll
          for (int hf = 0; hf < 2; ++hf) {
#pragma unroll
              for (int k = 0; k < 8; ++k) { const int rg = 8 * hf + k, q = crow(rg, hi); const float rl = __builtin_amdgcn_rcpf(WSF[wid * 32 + q]);
                  stg[(q & 15) * 64 + l31] = f2bf16(z[0][rg] * rl); stg[(q & 15) * 64 + 32 + l31] = f2bf16(z[1][rg] * rl); }
#pragma unroll
              for (int i = 0; i < 2; ++i) { const int q15 = i * 8 + (lane >> 3), ch = lane & 7; const v4u v = *(const LAS v4u*)(stg + q15 * 64 + ch * 8); const int t = ((S0 + 32 * wid + 16 * hf + q15) << dsh) + r;
                  *(GAS v4u*)(OPART + ((size_t)g * M + rowbase + t) * AO + hh * 64 + ch * 8) = v; } } }
        __syncthreads();
    }
#undef ATT_LOAD
}
__device__ __forceinline__ void attn_combine(const bf16* OPART, const float* LSE, bf16* OATT, int gthread, int nthreads) {
    for (int it = gthread; it < M * 32; it += nthreads) { const int bt = it >> 5, c8 = it & 31, hh = c8 >> 3;
        const float l0 = LSE[((size_t)0 * M + bt) * 4 + hh], l1 = LSE[((size_t)1 * M + bt) * 4 + hh], l2 = LSE[((size_t)2 * M + bt) * 4 + hh];
        const float mx = fmaxf(l0, fmaxf(l1, l2)); float w0 = __builtin_amdgcn_exp2f(l0 - mx), w1 = __builtin_amdgcn_exp2f(l1 - mx), w2 = __builtin_amdgcn_exp2f(l2 - mx);
        const float inv = 1.0f / (w0 + w1 + w2); w0 *= inv; w1 *= inv; w2 *= inv;
        const v4u a = *(const GAS v4u*)(OPART + ((size_t)0 * M + bt) * AO + c8 * 8), bq = *(const GAS v4u*)(OPART + ((size_t)1 * M + bt) * AO + c8 * 8), c = *(const GAS v4u*)(OPART + ((size_t)2 * M + bt) * AO + c8 * 8);
        const unsigned aw[4] = {a.x, a.y, a.z, a.w}, bw[4] = {bq.x, bq.y, bq.z, bq.w}, cw[4] = {c.x, c.y, c.z, c.w}; unsigned ow[4];
#pragma unroll
        for (int e = 0; e < 4; ++e) { const float lo = w0 * __uint_as_float(aw[e] << 16) + w1 * __uint_as_float(bw[e] << 16) + w2 * __uint_as_float(cw[e] << 16);
            const float hi_ = w0 * __uint_as_float(aw[e] & 0xffff0000u) + w1 * __uint_as_float(bw[e] & 0xffff0000u) + w2 * __uint_as_float(cw[e] & 0xffff0000u); ow[e] = pk2(lo, hi_); }
        *(GAS v4u*)(OATT + (size_t)bt * 1280 + c8 * 8) = (v4u){ow[0], ow[1], ow[2], ow[3]}; }
}
}


__device__ __forceinline__ void xs_prepass(const bf16* Fm, const float* mu, bf16* XS, int gthread, int nthreads) {
    for (int it = gthread; it < M * 32; it += nthreads) { const int bt = it >> 5, ch = it & 31, t = bt & (SEQ - 1), gcol = 3072 + ch * 8, kind = ch >> 3;
        const v4u cur = *(const GAS v4u*)(Fm + (size_t)bt * NF + gcol); v4u prv = (v4u){0u, 0u, 0u, 0u}; if (t > 0) prv = *(const GAS v4u*)(Fm + (size_t)(bt - 1) * NF + gcol);
        const f32x4 m0 = *(const GAS f32x4*)(mu + gcol), m1 = *(const GAS f32x4*)(mu + gcol + 4);
        const unsigned cw[4] = {cur.x, cur.y, cur.z, cur.w}, pw[4] = {prv.x, prv.y, prv.z, prv.w}; const float mm[8] = {m0.x, m0.y, m0.z, m0.w, m1.x, m1.y, m1.z, m1.w}; float xs[8];
#pragma unroll
        for (int e = 0; e < 4; ++e) { const float c0 = __uint_as_float(cw[e] << 16), c1 = __uint_as_float(cw[e] & 0xffff0000u), p0 = __uint_as_float(pw[e] << 16), p1 = __uint_as_float(pw[e] & 0xffff0000u);
            xs[2 * e] = c0 + (p0 - c0) * mm[2 * e]; xs[2 * e + 1] = c1 + (p1 - c1) * mm[2 * e + 1]; }
        const float sc = kind == 0 ? 2.0f : 1.0f;
#pragma unroll
        for (int e = 0; e < 8; ++e) { const float y = __builtin_amdgcn_rcpf(1.0f + __builtin_amdgcn_exp2f(-LOG2E * sc * xs[e])); xs[e] = kind == 0 ? 2.0f * y - 1.0f : (kind == 1 ? xs[e] : y); }
        *(GAS v4u*)(XS + (size_t)bt * 256 + ch * 8) = (v4u){pk2(xs[0], xs[1]), pk2(xs[2], xs[3]), pk2(xs[4], xs[5]), pk2(xs[6], xs[7])}; }
}
namespace rw {
typedef short s16x8 __attribute__((ext_vector_type(8)));
typedef short v4i16 __attribute__((ext_vector_type(4)));
typedef float f32x16 __attribute__((ext_vector_type(16)));
constexpr int LWP = 68;
constexpr int U = 9216, PT = 144;
constexpr int O_R = 0 * U, O_K = 1 * U, O_V = 2 * U, O_TW = 3 * U, O_FA = 4 * U, O_SG0 = 5 * U, O_SG1 = 6 * U, O_LW = 7 * U  , O_AA = 9 * U, O_GD = 10 * U, O_ARB = 11 * U, O_ARK = 12 * U, O_XT2 = 13 * U;
constexpr int O_AT = O_R, O_RT = O_K, O_BH = O_TW, O_KH = O_FA, O_ABT = O_LW  , O_AAK = O_AA, O_XT1 = O_AA;
constexpr int O_PF = O_R, O_QF = O_SG0  , O_GT = O_FA, O_Y0T = O_LW;
constexpr int O_TD = 14 * U;
constexpr int O_MISC = 131072 + 1024;
constexpr int M_W0 = 0, M_A0 = 64, M_KK = 128, M_KA = 192, M_RK = 256, M_LNW = 320, M_LNB = 384, M_INV = 448, M_BON = 512, M_GC = 576, M_CUMC = 640, M_SEGT = 704, M_SEGO = 1216, M_STAT = 1728, M_MU = 1984, M_CNT = 2432;
constexpr int O_TB = (O_MISC + (M_CNT + 1) * 4 + 15) & ~15;
static_assert(O_TD + 2048 <= 131072 && O_TB + 2 * 2560 <= LDS_BYTES && 64 * LWP * 4 <= 2 * U, "rwkv lds map");
__device__ __forceinline__ int crow(int r, int hi) { return (r & 3) + 8 * (r >> 2) + 4 * hi; }
__device__ __forceinline__ int boff(int row, int col) { return row * PT + col * 2; }
__device__ __forceinline__ float fsig(float x) { return __builtin_amdgcn_rcpf(1.0f + __builtin_amdgcn_exp2f(-LOG2E * x)); }
__device__ __forceinline__ float fexp(float x) { return __builtin_amdgcn_exp2f(LOG2E * x); }
#define RW_DPP(v, ctrl) __builtin_bit_cast(float, __builtin_amdgcn_update_dpp(0, __builtin_bit_cast(int, (v)), (ctrl), 0xf, 0xf, true))
__device__ __forceinline__ float sum8(float v) { v += RW_DPP(v, 0xB1); v += RW_DPP(v, 0x4E); v += RW_DPP(v, 0x141); return v; }
__device__ __forceinline__ unsigned long long pk4(float a, float b, float c, float d) { return (unsigned long long)pk2(a, b) | ((unsigned long long)pk2(c, d) << 32); }
__device__ __forceinline__ f32x4 up4(unsigned long long w) { const unsigned lo = (unsigned)w, hi = (unsigned)(w >> 32); return (f32x4){__uint_as_float(lo << 16), __uint_as_float(lo & 0xffff0000u), __uint_as_float(hi << 16), __uint_as_float(hi & 0xffff0000u)}; }
__device__ __forceinline__ s16x8 pack8(const f32x16& a, int s) { s16x8 r;
#pragma unroll
    for (int e = 0; e < 4; ++e) { const unsigned w = pk2(a[8 * s + 2 * e], a[8 * s + 2 * e + 1]); r[2 * e] = (short)(w & 0xffffu); r[2 * e + 1] = (short)(w >> 16); }
    return r; }
__device__ __forceinline__ s16x8 fragN(const LAS unsigned char* Mt, int row0, int ks, int l31, int hi) { return *(const LAS s16x8*)(Mt + (l31 * PT + hi * 16) + (row0 * PT + ks * 32)); }
__device__ __forceinline__ s16x8 fragT(const LAS unsigned char* Mt, int ch0, int ks, int lane) {
    const int g = lane >> 4, q = (lane & 15) >> 2, p = lane & 3;
    const LAS unsigned char* a0 = Mt + ((8 * (g >> 1) + q) * PT + (16 * (g & 1) + 4 * p) * 2) + (16 * ks * PT + ch0 * 2);
    const v4i16 lo = __builtin_amdgcn_ds_read_tr16_b64_v4i16((LAS v4i16*)a0), hi4 = __builtin_amdgcn_ds_read_tr16_b64_v4i16((LAS v4i16*)(a0 + 4 * PT));
    return (s16x8){lo[0], lo[1], lo[2], lo[3], hi4[0], hi4[1], hi4[2], hi4[3]}; }
#define RW_ZERO16 (f32x16){0.f, 0.f, 0.f, 0.f, 0.f, 0.f, 0.f, 0.f, 0.f, 0.f, 0.f, 0.f, 0.f, 0.f, 0.f, 0.f}
#define RW_MMA(acc, AF, BF) do { _Pragma("unroll") for (int ks_ = 0; ks_ < 4; ++ks_) { const int ks = ks_; acc = __builtin_amdgcn_mfma_f32_32x32x16_bf16(AF, BF, acc, 0, 0, 0); } } while (0)
__device__ __forceinline__ void ctile(LAS unsigned char* lds, int type, int tb, int sb, int l31, int hi) {
    const int t = 32 * tb + l31;
    const LAS unsigned char* Am = lds + ((type & 1) ? O_KH : O_BH); const LAS unsigned char* Bm = lds + ((type & 2) ? O_RT : O_AT); const bool incl = (type & 2) != 0;
    f32x16 acc = RW_ZERO16;
    if (sb <= tb) RW_MMA(acc, fragN(Am, 32 * sb, ks, l31, hi), fragN(Bm, 32 * tb, ks, l31, hi));
    const int lim = (sb < tb) ? 64 : ((sb == tb) ? (incl ? l31 + 1 : l31) : 0);
#pragma unroll
    for (int q = 0; q < 4; ++q) { const int s0 = 32 * sb + 8 * q + 4 * hi; float o[4];
#pragma unroll
        for (int e = 0; e < 4; ++e) { const int sl = 8 * q + 4 * hi + e; o[e] = (sl < lim) ? acc[4 * q + e] : 0.f; }
        if (type == 0) {
#pragma unroll
            for (int e = 0; e < 4; ++e) *(LAS float*)(lds + O_ABT + (s0 + e) * 256 + t * 4) = o[e];
        } else { const int dst = type == 1 ? O_AAK : (type == 2 ? O_ARB : O_ARK); *(LAS unsigned long long*)(lds + dst + boff(t, s0)) = pk4(o[0], o[1], o[2], o[3]); } }
}
__device__ __forceinline__ void rwkv_chain(LAS unsigned char* lds, const Args& A, int chain, int wave_, int par, int nW) {
    const int tid0 = (wave_ << 6) | lane_fresh();
    const int b = chain >> 4, h = chain & 15;
    const bf16* Fm = (const bf16*)(A.ws + WS_F); bf16* ORW = (bf16*)(A.ws + WS_ACAT) + 256;
    LAS float* MS = (LAS float*)(lds + O_MISC);
    s16x8 lw[8];
    { const int tid = tid0, lane = tid & 63, l31 = lane & 31, hi = lane >> 5, wid = wave_;
      if (tid == 0) *(LAS unsigned*)(MS + M_CNT) = 0u;
      if (tid < 64) { const int c = h * 64 + tid; MS[M_W0 + tid] = A.in[9][c]; MS[M_A0 + tid] = A.in[11][c]; MS[M_KK + tid] = A.in[14][c]; MS[M_KA + tid] = A.in[15][c];
          MS[M_RK + tid] = A.in[16][c]; MS[M_LNW + tid] = A.in[17][c]; MS[M_LNB + tid] = A.in[18][c]; }
      if (tid < 448) { const int gc = tid < 192 ? (tid >> 6) * 1024 + h * 64 + (tid & 63) : 3072 + (tid - 192); MS[M_MU + tid] = A.in[8][gc]; }
      if (wid < 4) { const int cb = wid >> 1; const bf16* w1 = (const bf16*)(A.ws + WS_LORA) + (size_t)h * 4096 + (size_t)(32 * cb + l31) * 64 + 8 * hi; const bf16* w2 = w1 + 65536;
#pragma unroll
          for (int ks = 0; ks < 4; ++ks) { lw[ks] = *(const GAS s16x8*)(w1 + 16 * ks); lw[4 + ks] = *(const GAS s16x8*)(w2 + 16 * ks); }
      } else { const int ib = (wid - 4) >> 1; const bf16* w3 = (const bf16*)(A.ws + WS_LORA + 262144) + (size_t)h * 8192 + (size_t)(32 * ib + l31) * 128 + 8 * hi;
#pragma unroll
          for (int ks = 0; ks < 8; ++ks) lw[ks] = *(const GAS s16x8*)(w3 + 16 * ks); }
    }
    v4u pc[7], pp[3]; const bf16* XSm = (const bf16*)(A.ws + WS_XS);
#define RW_LOAD(cc) do { _Pragma("unroll") for (int q = 0; q < 7; ++q) { const int idx = tid0 + 512 * q; \
        if (q < 3) { const int row = (idx & 511) >> 3, gcol = q * 1024 + h * 64 + (idx & 7) * 8; const int tl = 64 * (cc) + row; const bf16* gp = Fm + ((size_t)b * SEQ + tl) * NF + gcol; \
            pc[q] = *(const GAS v4u*)gp; pp[q] = (v4u){0u, 0u, 0u, 0u}; if (tl > 0) pp[q] = *(const GAS v4u*)(gp - NF); } \
        else { const int e = idx - 1536; pc[q] = *(const GAS v4u*)(XSm + ((size_t)b * SEQ + 64 * (cc) + (e >> 5)) * 256 + (e & 31) * 8); } } } while (0)
    RW_LOAD(par);
    gu32* flagp = (gu32*)(A.ws + WS_CTL) + CW_RWF + chain * 64;
    unsigned char* hx = A.ws + WS_HX + (size_t)chain * 2 * U;
    __syncthreads();
    for (int c = par; c < SEQ / 64; c += nW) {
        int tidv = tid0; asm volatile("" : "+v"(tidv));
        const int tid = tidv, lane = tid & 63, l31 = lane & 31, hi = lane >> 5, wid = wave_;
        v4u rwk = (v4u){0u, 0u, 0u, 0u}, kwk = (v4u){0u, 0u, 0u, 0u}; float invr = 0.f;
        { const int row = tid >> 3, ch = tid & 7;
          f32x4 mq[3][2], kq2[2];
#pragma unroll
          for (int q = 0; q < 3; ++q) { mq[q][0] = *(const LAS f32x4*)(MS + M_MU + q * 64 + ch * 8); mq[q][1] = *(const LAS f32x4*)(MS + M_MU + q * 64 + ch * 8 + 4); }
          kq2[0] = *(const LAS f32x4*)(MS + M_KK + ch * 8); kq2[1] = *(const LAS f32x4*)(MS + M_KK + ch * 8 + 4);
          asm volatile("" :: "v"(mq[0][0]), "v"(mq[0][1]), "v"(mq[1][0]), "v"(mq[1][1]), "v"(mq[2][0]), "v"(mq[2][1]), "v"(kq2[0]), "v"(kq2[1]));
#pragma unroll
          for (int q = 0; q < 3; ++q) {
            const f32x4 m0 = mq[q][0], m1 = mq[q][1];
            const unsigned cw[4] = {pc[q].x, pc[q].y, pc[q].z, pc[q].w}, pw[4] = {pp[q].x, pp[q].y, pp[q].z, pp[q].w}; const float mm[8] = {m0.x, m0.y, m0.z, m0.w, m1.x, m1.y, m1.z, m1.w};
            float xs[8];
#pragma unroll
            for (int e = 0; e < 4; ++e) { const float c0 = __uint_as_float(cw[e] << 16), c1 = __uint_as_float(cw[e] & 0xffff0000u), p0 = __uint_as_float(pw[e] << 16), p1 = __uint_as_float(pw[e] & 0xffff0000u);
                xs[2 * e] = c0 + (p0 - c0) * mm[2 * e]; xs[2 * e + 1] = c1 + (p1 - c1) * mm[2 * e + 1]; }
            const int dst = q == 0 ? O_R : (q == 1 ? O_K : O_V);
            if (q == 1) { float ss = 0.f; const f32x4 k0 = kq2[0], k1 = kq2[1]; const float kq[8] = {k0.x, k0.y, k0.z, k0.w, k1.x, k1.y, k1.z, k1.w};
#pragma unroll
                for (int e = 0; e < 8; ++e) { const float kv = xs[e] * kq[e]; ss += kv * kv; }
                ss = sum8(ss);
                invr = __builtin_amdgcn_rsqf(fmaxf(ss, 1e-24f)); }
            const v4u pkd = (v4u){pk2(xs[0], xs[1]), pk2(xs[2], xs[3]), pk2(xs[4], xs[5]), pk2(xs[6], xs[7])};
            if (q == 0) rwk = pkd; else if (q == 1) kwk = pkd; else *(LAS v4u*)(lds + dst + boff(row, ch * 8)) = pkd;
          } }
#pragma unroll
        for (int q = 3; q < 7; ++q) { const int e = tid + 512 * q - 1536, row = e >> 5, ch = e & 31, kind = ch >> 3; const int dst = kind == 0 ? O_TW : kind == 1 ? O_FA : kind == 2 ? O_SG0 : O_SG1;
            *(LAS v4u*)(lds + dst + boff(row, (ch & 7) * 8)) = pc[q]; }
        if (c + nW < SEQ / 64) RW_LOAD(c + nW);
        __syncthreads();
        if (wid < 4) { const int tb = wid & 1, cb = wid >> 1, t = 32 * tb + l31;
            s16x8 fb[8]; f32x4 bw[4], ba[4];
#pragma unroll
            for (int ks = 0; ks < 4; ++ks) { fb[ks] = fragN(lds + O_TW, 32 * tb, ks, l31, hi); fb[4 + ks] = fragN(lds + O_FA, 32 * tb, ks, l31, hi); }
#pragma unroll
            for (int q = 0; q < 4; ++q) { const int c0 = 32 * cb + 8 * q + 4 * hi; bw[q] = *(const LAS f32x4*)(MS + M_W0 + c0); ba[q] = *(const LAS f32x4*)(MS + M_A0 + c0); }
            asm volatile("" :: "v"(fb[0]), "v"(fb[1]), "v"(fb[2]), "v"(fb[3]), "v"(fb[4]), "v"(fb[5]), "v"(fb[6]), "v"(fb[7]), "v"(bw[0]), "v"(bw[1]), "v"(bw[2]), "v"(bw[3]), "v"(ba[0]), "v"(ba[1]), "v"(ba[2]), "v"(ba[3]));
            f32x16 acc, acc2;
#pragma unroll
            for (int q = 0; q < 4; ++q)
#pragma unroll
                for (int e = 0; e < 4; ++e) { acc[4 * q + e] = bw[q][e]; acc2[4 * q + e] = ba[q][e]; }
#pragma unroll
            for (int ks = 0; ks < 4; ++ks) acc = __builtin_amdgcn_mfma_f32_32x32x16_bf16(lw[ks], fb[ks], acc, 0, 0, 0);
#pragma unroll
            for (int ks = 0; ks < 4; ++ks) acc2 = __builtin_amdgcn_mfma_f32_32x32x16_bf16(lw[4 + ks], fb[4 + ks], acc2, 0, 0, 0);
#pragma unroll
            for (int q = 0; q < 4; ++q) { const int c0 = 32 * cb + 8 * q + 4 * hi; f32x4 o;
#pragma unroll
                for (int e = 0; e < 4; ++e) o[e] = -0.6065306597126334f * fsig(acc[4 * q + e]);
                *(LAS f32x4*)(lds + O_LW + t * (LWP * 4) + c0 * 4) = o; }
#pragma unroll
            for (int q = 0; q < 4; ++q) { const int c0 = 32 * cb + 8 * q + 4 * hi;
                *(LAS unsigned long long*)(lds + O_AA + boff(t, c0)) = pk4(fsig(acc2[4 * q]), fsig(acc2[4 * q + 1]), fsig(acc2[4 * q + 2]), fsig(acc2[4 * q + 3])); }
        } else { const int w4 = wid - 4, tb = w4 & 1, ib = w4 >> 1;
            s16x8 fb[8];
#pragma unroll
            for (int ks = 0; ks < 4; ++ks) { fb[ks] = fragN(lds + O_SG0, 32 * tb, ks, l31, hi); fb[4 + ks] = fragN(lds + O_SG1, 32 * tb, ks, l31, hi); }
            asm volatile("" :: "v"(fb[0]), "v"(fb[1]), "v"(fb[2]), "v"(fb[3]), "v"(fb[4]), "v"(fb[5]), "v"(fb[6]), "v"(fb[7]));
            f32x16 acc = RW_ZERO16;
#pragma unroll
            for (int ks = 0; ks < 8; ++ks) acc = __builtin_amdgcn_mfma_f32_32x32x16_bf16(lw[ks], fb[ks], acc, 0, 0, 0);
#pragma unroll
            for (int q = 0; q < 4; ++q) *(LAS unsigned long long*)(lds + O_GD + (((ib * 2 + tb) * 4 + q) * 64 + lane) * 8) = pk4(acc[4 * q], acc[4 * q + 1], acc[4 * q + 2], acc[4 * q + 3]);
        }
        __syncthreads();
        const int cc2 = tid & 63, seg2 = tid >> 6; float v8[8];
        { LAS float* LW = (LAS float*)(lds + O_LW); float tot = 0.f;
#pragma unroll
            for (int q = 0; q < 8; ++q) { v8[q] = LW[(8 * seg2 + q) * LWP + cc2]; tot += v8[q]; }
            MS[M_SEGT + seg2 * 64 + cc2] = tot; }
        __syncthreads();
        { LAS float* LW = (LAS float*)(lds + O_LW); float off = 0.f, total = 0.f;
#pragma unroll
            for (int sg = 0; sg < 8; ++sg) { const float st = MS[M_SEGT + sg * 64 + cc2]; total += st; off += (sg < seg2) ? st : 0.f; }
            float run = off;
#pragma unroll
            for (int q = 0; q < 8; ++q) { run += v8[q]; LW[(8 * seg2 + q) * LWP + cc2] = run; }
            if (seg2 == 0) MS[M_GC + cc2] = fexp(total); }
        __syncthreads();
        { const int t = tid >> 3, jg = tid & 7, j0 = 8 * jg, seg = t >> 3, tp = t > 0 ? t - 1 : 0, segp = tp >> 3; const LAS float* LW = (const LAS float*)(lds + O_LW);
            const v4u rv = rwk, kv = kwk, av = *(const LAS v4u*)(lds + O_AA + boff(t, j0));
            const float inv = invr; float at[8], rt[8], bh[8], kh[8], bon = 0.f;
            f32x4 Lq[2][8];
#pragma unroll
            for (int hf = 0; hf < 2; ++hf) { const int jj = j0 + 4 * hf;
                Lq[hf][0] = *(const LAS f32x4*)(LW + t * LWP + jj); Lq[hf][2] = *(const LAS f32x4*)(LW + tp * LWP + jj);
                Lq[hf][5] = *(const LAS f32x4*)(MS + M_KK + jj); Lq[hf][6] = *(const LAS f32x4*)(MS + M_KA + jj); Lq[hf][7] = *(const LAS f32x4*)(MS + M_RK + jj); }
            asm volatile("" ::: "memory");
#pragma unroll
            for (int hf = 0; hf < 2; ++hf) {
                const f32x4 lwc = Lq[hf][0], lwp = Lq[hf][2], kkv = Lq[hf][5], kav = Lq[hf][6], rkv = Lq[hf][7];
                const f32x4 a4 = up4(hf ? ((unsigned long long)av.w << 32 | av.z) : ((unsigned long long)av.y << 32 | av.x)), k4 = up4(hf ? ((unsigned long long)kv.w << 32 | kv.z) : ((unsigned long long)kv.y << 32 | kv.x)),
                            r4 = up4(hf ? ((unsigned long long)rv.w << 32 | rv.z) : ((unsigned long long)rv.y << 32 | rv.x));
#pragma unroll
                for (int e = 0; e < 4; ++e) { const int x = 4 * hf + e;
                    const float cum = lwc[e]; const float cump = t > 0 ? lwp[e] : 0.f;
                    const float e1 = fexp(cum), e0 = fexp(cump), ei = __builtin_amdgcn_rcpf(e1);
                    const float a = a4[e], kraw = k4[e], rr = r4[e];
                    const float kk = kraw * kkv[e] * inv, bq = kk * a, kp = kraw * (1.0f + (a - 1.0f) * kav[e]);
                    at[x] = -kk * e0; rt[x] = rr * e1; bh[x] = bq * ei; kh[x] = kp * ei; bon += rr * kp * rkv[e]; } }
            bon = sum8(bon); if (jg == 0) MS[M_BON + t] = bon;
            const int o = boff(t, j0);
            *(LAS v4u*)(lds + O_AT + o) = (v4u){pk2(at[0], at[1]), pk2(at[2], at[3]), pk2(at[4], at[5]), pk2(at[6], at[7])};
            *(LAS v4u*)(lds + O_RT + o) = (v4u){pk2(rt[0], rt[1]), pk2(rt[2], rt[3]), pk2(rt[4], rt[5]), pk2(rt[6], rt[7])};
            *(LAS v4u*)(lds + O_BH + o) = (v4u){pk2(bh[0], bh[1]), pk2(bh[2], bh[3]), pk2(bh[4], bh[5]), pk2(bh[6], bh[7])};
            *(LAS v4u*)(lds + O_KH + o) = (v4u){pk2(kh[0], kh[1]), pk2(kh[2], kh[3]), pk2(kh[4], kh[5]), pk2(kh[6], kh[7])}; }
        __syncthreads();
        if (wid < 6) { const int type = wid >= 3 ? 1 : 0, idx = wid - 3 * type;
            ctile(lds, type, idx > 0, idx > 1, l31, hi);
        }
        __syncthreads();
        f32x16 r0 = RW_ZERO16, r1 = RW_ZERO16; s16x8 af[2] = {(s16x8){0, 0, 0, 0, 0, 0, 0, 0}, (s16x8){0, 0, 0, 0, 0, 0, 0, 0}};
        f32x16 yacc = RW_ZERO16;
        if (wid < 2) {
            const int B = wid, o16 = lane >> 5, c16 = (lane >> 1) & 15, rh = lane & 1, b16 = 2 * B + o16;
            const LAS float* ABTb = (const LAS float*)(lds + O_ABT) + (16 * b16) * 64 + 16 * b16 + 8 * rh;
            f32x4 aL0[11], aL1[15];
#pragma unroll
            for (int s = 0; s < 15; ++s) { if (s < 11) aL0[s] = *(const LAS f32x4*)(ABTb + s * 64); aL1[s] = *(const LAS f32x4*)(ABTb + s * 64 + 4); }
            float part[8], tsv[16];
#pragma unroll
            for (int e = 0; e < 8; ++e) part[e] = (8 * rh + e == c16) ? 1.f : 0.f;
            const bool zl = (rh == 1) && (o16 == 1);
            LAS unsigned char* TBp = lds + O_TB + B * 2560 + (zl ? (16 + c16) * 2 : (16 * o16) * 80 + (16 * o16 + c16) * 2);
#pragma unroll
            for (int s = 0; s < 16; ++s) {
                const int src = __builtin_bit_cast(int, part[s & 7]);
                const float ts = __builtin_bit_cast(float, s < 8 ? __builtin_amdgcn_update_dpp(src, src, 0xA0, 0xf, 0xf, false) : __builtin_amdgcn_update_dpp(src, src, 0xF5, 0xf, 0xf, false));
                tsv[s] = ts;
                *(LAS unsigned short*)(TBp + s * 80) = zl ? (unsigned short)0 : f2bf16(ts);
#define RW_FMAC(acc_, a_, b_) asm("v_fmac_f32 %0, %1, %2" : "+v"(acc_) : "v"(a_), "v"(b_))
                if (s < 11) { const f32x4 a4 = aL0[s < 11 ? s : 0]; RW_FMAC(part[0], a4[0], ts); RW_FMAC(part[1], a4[1], ts); RW_FMAC(part[2], a4[2], ts); RW_FMAC(part[3], a4[3], ts); }
                if (s < 15) { const f32x4 a4 = aL1[s < 15 ? s : 0]; RW_FMAC(part[4], a4[0], ts); RW_FMAC(part[5], a4[1], ts); RW_FMAC(part[6], a4[2], ts); RW_FMAC(part[7], a4[3], ts); } }
#undef RW_FMAC
            { LAS unsigned char* td = lds + O_TD + (b16 * 16 + c16) * 32 + 16 * rh;
              const v4u lo4 = (v4u){pk2(tsv[0], tsv[1]), pk2(tsv[2], tsv[3]), pk2(tsv[4], tsv[5]), pk2(tsv[6], tsv[7])}, hi4 = (v4u){pk2(tsv[8], tsv[9]), pk2(tsv[10], tsv[11]), pk2(tsv[12], tsv[13]), pk2(tsv[14], tsv[15])};
              *(LAS v4u*)td = rh ? hi4 : lo4; }
            const int B2 = l31 >> 4, r15 = l31 & 15; const s16x8 zf = (s16x8){0, 0, 0, 0, 0, 0, 0, 0}; const bool mine = (B2 == B);
            float av[8];
#pragma unroll
            for (int e = 0; e < 8; ++e) av[e] = *((const LAS float*)(lds + O_ABT) + (32 * B + 8 * hi + e) * 64 + 32 * B + 16 + r15);
            const unsigned w0 = pk2(av[0], av[1]), w1 = pk2(av[2], av[3]), w2 = pk2(av[4], av[5]), w3 = pk2(av[6], av[7]);
            const s16x8 a_own = (s16x8){(short)(w0 & 0xffff), (short)(w0 >> 16), (short)(w1 & 0xffff), (short)(w1 >> 16), (short)(w2 & 0xffff), (short)(w2 >> 16), (short)(w3 & 0xffff), (short)(w3 >> 16)};
            const s16x8 b_own = *(const LAS s16x8*)(lds + O_TD + ((2 * B) * 16 + r15) * 32 + 16 * hi);
            f32x16 d = RW_ZERO16;
            d = __builtin_amdgcn_mfma_f32_32x32x16_bf16(mine ? a_own : zf, mine ? b_own : zf, d, 0, 0, 0);
            const LAS unsigned char* tbp = lds + O_TB + B * 2560 + (16 + r15) * 80 + (16 + 4 * hi) * 2;
            const unsigned long long tlo = *(const LAS unsigned long long*)tbp, thi = *(const LAS unsigned long long*)(tbp + 16);
            const s16x8 t_own = (s16x8){(short)(tlo & 0xffff), (short)((tlo >> 16) & 0xffff), (short)((tlo >> 32) & 0xffff), (short)(tlo >> 48), (short)(thi & 0xffff), (short)((thi >> 16) & 0xffff), (short)((thi >> 32) & 0xffff), (short)(thi >> 48)};
            const s16x8 dsel = B ? pack8(d, 1) : pack8(d, 0);
            f32x16 ee = RW_ZERO16;
            ee = __builtin_amdgcn_mfma_f32_32x32x16_bf16(mine ? t_own : zf, dsel, ee, 0, 0, 0);
            if (mine) {
#pragma unroll
                for (int k = 0; k < 8; ++k) { const float val = B ? ee[8 + k] : ee[k]; *(LAS unsigned short*)(lds + O_TB + B * 2560 + (16 + crow(k, hi)) * 80 + r15 * 2) = f2bf16(val); } }
        } else if (wid < 4) {
            ctile(lds, wid, 0, 0, l31, hi); ctile(lds, wid, 0, 1, l31, hi); ctile(lds, wid, 1, 0, l31, hi);
        } else { const int ct = wid - 4;
            if (ct < 2) {
#pragma unroll
                for (int rg = 0; rg < 16; ++rg) { r0[rg] = bf2f(*(const LAS unsigned short*)(lds + O_AT + boff(crow(rg, hi), 32 * ct + l31))); r1[rg] = bf2f(*(const LAS unsigned short*)(lds + O_AT + boff(32 + crow(rg, hi), 32 * ct + l31))); }
                ctile(lds, 2 + ct, 1, 1, l31, hi);
            } else {
#pragma unroll
                for (int ks = 0; ks < 2; ++ks) r0 = __builtin_amdgcn_mfma_f32_32x32x16_bf16(fragN(lds + O_AAK, 0, ks, l31, hi), fragT(lds + O_V, 32 * (ct - 2), ks, lane), r0, 0, 0, 0);
                RW_MMA(r1, fragN(lds + O_AAK, 32, ks, l31, hi), fragT(lds + O_V, 32 * (ct - 2), ks, lane)); }
            RW_MMA(yacc, fragT(lds + O_KH, 32 * (ct >> 1), ks, lane), fragT(lds + O_V, 32 * (ct & 1), ks, lane));
#pragma unroll
            for (int s = 0; s < 2; ++s) { const LAS float* ap = (const LAS float*)(lds + O_ABT) + (16 * s + 4 * hi) * 64 + 32 + l31; float v[8];
#pragma unroll
                for (int e = 0; e < 8; ++e) v[e] = ap[(8 * (e >> 2) + (e & 3)) * 64];
                const unsigned w0 = pk2(v[0], v[1]), w1 = pk2(v[2], v[3]), w2 = pk2(v[4], v[5]), w3 = pk2(v[6], v[7]);
                af[s] = (s16x8){(short)(w0 & 0xffff), (short)(w0 >> 16), (short)(w1 & 0xffff), (short)(w1 >> 16), (short)(w2 & 0xffff), (short)(w2 >> 16), (short)(w3 & 0xffff), (short)(w3 >> 16)}; }
        }
        __syncthreads();
        if (wid < 4) { RW_MMA(yacc, fragT(lds + O_V, 32 * (wid >> 1), ks, lane), fragN(lds + O_ARK, 32 * (wid & 1), ks, l31, hi)); }
        else { const int ct = wid - 4;
            s16x8 tf[2][2];
#pragma unroll
            for (int blk = 0; blk < 2; ++blk)
#pragma unroll
                for (int s = 0; s < 2; ++s) { const LAS unsigned char* tp_ = lds + O_TB + blk * 2560 + l31 * 80 + (16 * s + 4 * hi) * 2;
                    const unsigned long long lo = *(const LAS unsigned long long*)tp_, hi8 = *(const LAS unsigned long long*)(tp_ + 16);
                    tf[blk][s] = (s16x8){(short)(lo & 0xffff), (short)((lo >> 16) & 0xffff), (short)((lo >> 32) & 0xffff), (short)(lo >> 48), (short)(hi8 & 0xffff), (short)((hi8 >> 16) & 0xffff), (short)((hi8 >> 32) & 0xffff), (short)(hi8 >> 48)}; }
            f32x16 x0 = RW_ZERO16;
#pragma unroll
            for (int s = 0; s < 2; ++s) x0 = __builtin_amdgcn_mfma_f32_32x32x16_bf16(tf[0][s], pack8(r0, s), x0, 0, 0, 0);
#pragma unroll
            for (int s = 0; s < 2; ++s) r1 = __builtin_amdgcn_mfma_f32_32x32x16_bf16(af[s], pack8(x0, s), r1, 0, 0, 0);
            f32x16 x1 = RW_ZERO16;
#pragma unroll
            for (int s = 0; s < 2; ++s) x1 = __builtin_amdgcn_mfma_f32_32x32x16_bf16(tf[1][s], pack8(r1, s), x1, 0, 0, 0);
            const int dst = (ct < 2 ? O_XT1 : O_XT2), xr = 32 * (ct & 1) + l31;
#pragma unroll
            for (int q = 0; q < 4; ++q) {
                *(LAS unsigned long long*)(lds + dst + boff(xr, 8 * q + 4 * hi)) = pk4(x0[4 * q], x0[4 * q + 1], x0[4 * q + 2], x0[4 * q + 3]);
                *(LAS unsigned long long*)(lds + dst + boff(xr, 32 + 8 * q + 4 * hi)) = pk4(x1[4 * q], x1[4 * q + 1], x1[4 * q + 2], x1[4 * q + 3]); }
        }
        __syncthreads();
        unsigned long long hfr[4][2];
        const int ibx = wid < 4 ? (wid >> 1) : ((wid - 4) & 1);
#define RW_HLOAD() do { const unsigned char* hsrc_ = hx + (c & 1) * U; _Pragma("unroll") for (int f = 0; f < 4; ++f) { gu64* hp = (gu64*)(hsrc_ + ((((f >> 1) * 2 + ibx) * 2 + (f & 1)) * 64 + lane) * 16); \
            hfr[f][0] = __hip_atomic_load(hp, RLX_AGENT); hfr[f][1] = __hip_atomic_load(hp + 1, RLX_AGENT); } } while (0)
#pragma unroll
        for (int f = 0; f < 4; ++f) { hfr[f][0] = 0ull; hfr[f][1] = 0ull; }
        bool hgot = (c == 0);
        if (!hgot && (unsigned)__builtin_amdgcn_readfirstlane(__hip_atomic_load(flagp, RLX_AGENT)) >= (unsigned)c) { RW_HLOAD(); hgot = true; }
        if (wid < 4) { const int xb = wid >> 1, tb = wid & 1, t = 32 * tb + l31;
            s16x8 arb[4];
#pragma unroll
            for (int ks = 0; ks < 4; ++ks) arb[ks] = fragN(lds + O_ARB, 32 * tb, ks, l31, hi);
            f32x16 acc;
#pragma unroll
            for (int q = 0; q < 4; ++q) { const f32x4 rr = up4(*(const LAS unsigned long long*)(lds + O_RT + boff(t, 32 * xb + 8 * q + 4 * hi))); acc[4 * q] = rr[0]; acc[4 * q + 1] = rr[1]; acc[4 * q + 2] = rr[2]; acc[4 * q + 3] = rr[3]; }
            RW_MMA(acc, fragN(lds + O_XT1, 32 * xb, ks, l31, hi), arb[ks]);
#pragma unroll
            for (int s = 0; s < 2; ++s) *(LAS s16x8*)(lds + O_QF + (((xb * 2 + tb) * 2 + s) * 64 + lane) * 16) = pack8(acc, s);
            RW_MMA(yacc, fragN(lds + O_XT2, 32 * xb, ks, l31, hi), arb[ks]);
        } else { const int w4 = wid - 4, jb = w4 >> 1, yb = w4 & 1;
            f32x16 acc = RW_ZERO16;
            RW_MMA(acc, fragN(lds + O_XT1, 32 * jb, ks, l31, hi), fragT(lds + O_BH, 32 * yb, ks, lane));
            { const float gcl = MS[M_GC + 32 * yb + l31];
#pragma unroll
                for (int rg = 0; rg < 16; ++rg) acc[rg] *= gcl;
                if (jb == yb) {
#pragma unroll
                    for (int rg = 0; rg < 16; ++rg) if (crow(rg, hi) == l31) acc[rg] += gcl; } }
#pragma unroll
            for (int s = 0; s < 2; ++s) *(LAS s16x8*)(lds + O_PF + (((yb * 2 + jb) * 2 + s) * 64 + lane) * 16) = pack8(acc, s);
            RW_MMA(yacc, fragT(lds + O_BH, 32 * jb, ks, lane), fragN(lds + O_XT2, 32 * yb, ks, l31, hi));
#pragma unroll
            for (int q = 0; q < 4; ++q) { const f32x4 g4 = *(const LAS f32x4*)(MS + M_GC + 32 * jb + 8 * q + 4 * hi);
                yacc[4 * q] *= g4[0]; yacc[4 * q + 1] *= g4[1]; yacc[4 * q + 2] *= g4[2]; yacc[4 * q + 3] *= g4[3]; }
        }
        if (!hgot) { unsigned spins = 0;
            while ((unsigned)__builtin_amdgcn_readfirstlane(__hip_atomic_load(flagp, RLX_AGENT)) < (unsigned)c) { __builtin_amdgcn_s_sleep(1); if (++spins > (1u << 22)) break; }
            RW_HLOAD(); }
#undef RW_HLOAD
        __syncthreads();
        unsigned char* HFn = hx + ((c + 1) & 1) * U;
#define RW_HF(jb_, s_) ((s16x8){(short)(hfr[(jb_) * 2 + (s_)][0] & 0xffff), (short)((hfr[(jb_) * 2 + (s_)][0] >> 16) & 0xffff), (short)((hfr[(jb_) * 2 + (s_)][0] >> 32) & 0xffff), (short)(hfr[(jb_) * 2 + (s_)][0] >> 48), (short)(hfr[(jb_) * 2 + (s_)][1] & 0xffff), (short)((hfr[(jb_) * 2 + (s_)][1] >> 16) & 0xffff), (short)((hfr[(jb_) * 2 + (s_)][1] >> 32) & 0xffff), (short)(hfr[(jb_) * 2 + (s_)][1] >> 48)})
        int ib_ = 0, tb_ = 0;
        if (wid >= 4) { const int w4 = wid - 4, jp = w4 >> 1, ib = w4 & 1; f32x16 acc = yacc;
#pragma unroll
            for (int jb = 0; jb < 2; ++jb)
#pragma unroll
                for (int s = 0; s < 2; ++s) { const s16x8 pf = *(const LAS s16x8*)(lds + O_PF + (((jp * 2 + jb) * 2 + s) * 64 + lane) * 16); const s16x8 hf = RW_HF(jb, s);
                    acc = __builtin_amdgcn_mfma_f32_32x32x16_bf16(pf, hf, acc, 0, 0, 0); }
            if (c + 1 < SEQ / 64) {
#pragma unroll
                for (int s = 0; s < 2; ++s) { gu64* hp = (gu64*)(HFn + (((jp * 2 + ib) * 2 + s) * 64 + lane) * 16);
                    __hip_atomic_store(hp, (unsigned long long)pk2(acc[8 * s], acc[8 * s + 1]) | ((unsigned long long)pk2(acc[8 * s + 2], acc[8 * s + 3]) << 32), RLX_AGENT);
                    __hip_atomic_store(hp + 1, (unsigned long long)pk2(acc[8 * s + 4], acc[8 * s + 5]) | ((unsigned long long)pk2(acc[8 * s + 6], acc[8 * s + 7]) << 32), RLX_AGENT); }
            }
        } else { ib_ = wid >> 1; tb_ = wid & 1;
#pragma unroll
            for (int jb = 0; jb < 2; ++jb)
#pragma unroll
                for (int s = 0; s < 2; ++s) { const s16x8 hf = RW_HF(jb, s); const s16x8 qf = *(const LAS s16x8*)(lds + O_QF + (((jb * 2 + tb_) * 2 + s) * 64 + lane) * 16);
                    yacc = __builtin_amdgcn_mfma_f32_32x32x16_bf16(hf, qf, yacc, 0, 0, 0); }
            float s1 = 0.f, s2 = 0.f;
#pragma unroll
            for (int rg = 0; rg < 16; ++rg) { s1 += yacc[rg]; s2 += yacc[rg] * yacc[rg]; }
            s1 += __shfl_xor(s1, 32); s2 += __shfl_xor(s2, 32);
            if (hi == 0) { MS[M_STAT + ((tb_ * 2 + ib_) * 32 + l31) * 2] = s1; MS[M_STAT + ((tb_ * 2 + ib_) * 32 + l31) * 2 + 1] = s2; }
        }
        __syncthreads();
        if (wid >= 4 && c + 1 < SEQ / 64) { asm volatile("s_waitcnt vmcnt(0)" ::: "memory");
            if (lane == 0) { const unsigned old = __hip_atomic_fetch_add((LAS unsigned*)(MS + M_CNT), 1u, __ATOMIC_RELAXED, __HIP_MEMORY_SCOPE_WORKGROUP);
                if ((old & 3u) == 3u) __hip_atomic_store(flagp, (unsigned)(c + 1), RLX_AGENT); } }
        if (wid < 4) { const int t = 32 * tb_ + l31;
            const float S1 = MS[M_STAT + ((tb_ * 2 + 0) * 32 + l31) * 2] + MS[M_STAT + ((tb_ * 2 + 1) * 32 + l31) * 2], S2 = MS[M_STAT + ((tb_ * 2 + 0) * 32 + l31) * 2 + 1] + MS[M_STAT + ((tb_ * 2 + 1) * 32 + l31) * 2 + 1];
            const float bon = MS[M_BON + t];
            unsigned long long gq[4], vq[4]; f32x4 wq[4], bq4[4];
#pragma unroll
            for (int q = 0; q < 4; ++q) { const int i0 = 32 * ib_ + 8 * q + 4 * hi; gq[q] = *(const LAS unsigned long long*)(lds + O_GD + (((ib_ * 2 + tb_) * 4 + q) * 64 + lane) * 8); vq[q] = *(const LAS unsigned long long*)(lds + O_V + boff(t, i0));
                wq[q] = *(const LAS f32x4*)(MS + M_LNW + i0); bq4[q] = *(const LAS f32x4*)(MS + M_LNB + i0); }
            const float mean = S1 * (1.f / 64.f), var = fmaxf(S2 * (1.f / 64.f) - mean * mean, 0.f), rstd = __builtin_amdgcn_rsqf(var + LNX_EPS);
            bf16* op = ORW + ((size_t)b * SEQ + 64 * c + t) * 1280 + h * 64;
#pragma unroll
            for (int q = 0; q < 4; ++q) { const int i0 = 32 * ib_ + 8 * q + 4 * hi; float o[4];
                const f32x4 gv = up4(gq[q]), vv = up4(vq[q]);
                const f32x4 lnw = wq[q], lnb = bq4[q];
#pragma unroll
                for (int e = 0; e < 4; ++e) o[e] = ((yacc[4 * q + e] - mean) * rstd * lnw[e] + lnb[e] + bon * vv[e]) * gv[e];
                *(GAS unsigned long long*)(op + i0) = pk4(o[0], o[1], o[2], o[3]); } }
        __syncthreads();
    }
#undef RW_LOAD
#undef RW_HF
}
#undef RW_ZERO16
#undef RW_MMA
}

template <int MODE>
__device__ __forceinline__ void row_pass(int lane, const float* xrow, const bf16* zrow, const float* g1, const float* g2, bf16* hrow, const bf16* z2row, const float* g3, float* orow) {
    const float* g23 = MODE == 0 ? g2 : g3;
    v4u zw[2], z2w[2]; f32x4 x[2][2], ga[2][2], gb[2][2]; float z[2][8];
#pragma unroll
    for (int jj = 0; jj < 2; ++jj) { const int eb = 8 * (64 * jj + lane); zw[jj] = *(const GAS v4u*)(zrow + eb); if (MODE == 1) z2w[jj] = *(const GAS v4u*)(z2row + eb);
        x[jj][0] = *(const GAS f32x4*)(xrow + eb); x[jj][1] = *(const GAS f32x4*)(xrow + eb + 4); }
#pragma unroll
    for (int jj = 0; jj < 2; ++jj) { const int eb = 8 * (64 * jj + lane); ga[jj][0] = *(const GAS f32x4*)(g1 + eb); ga[jj][1] = *(const GAS f32x4*)(g1 + eb + 4); gb[jj][0] = *(const GAS f32x4*)(g23 + eb); gb[jj][1] = *(const GAS f32x4*)(g23 + eb + 4); }
    float s = 0.f;
#pragma unroll
    for (int jj = 0; jj < 2; ++jj) { const unsigned w[4] = {zw[jj].x, zw[jj].y, zw[jj].z, zw[jj].w};
#pragma unroll
        for (int e = 0; e < 4; ++e) { z[jj][2 * e] = __uint_as_float(w[e] << 16); z[jj][2 * e + 1] = __uint_as_float(w[e] & 0xffff0000u); s += z[jj][2 * e] * z[jj][2 * e] + z[jj][2 * e + 1] * z[jj][2 * e + 1]; } }
    const float rs = 1.0f / sqrtf(wave_sum(s) * (1.f / D) + NORM_EPS); float s2 = 0.f;
#pragma unroll
    for (int jj = 0; jj < 2; ++jj)
#pragma unroll
        for (int hf = 0; hf < 2; ++hf)
#pragma unroll
            for (int e = 0; e < 4; ++e) { const float v = x[jj][hf][e] + z[jj][4 * hf + e] * rs * ga[jj][hf][e]; x[jj][hf][e] = v; s2 += v * v; }
    if (MODE == 0) { const float rs2 = 1.0f / sqrtf(wave_sum(s2) * (1.f / D) + NORM_EPS);
#pragma unroll
        for (int jj = 0; jj < 2; ++jj) { const int eb = 8 * (64 * jj + lane); const f32x4 a = x[jj][0] * rs2 * gb[jj][0], c = x[jj][1] * rs2 * gb[jj][1];
            *(GAS v4u*)(hrow + eb) = (v4u){pk2(a.x, a.y), pk2(a.z, a.w), pk2(c.x, c.y), pk2(c.z, c.w)}; }
    } else { float s3 = 0.f;
#pragma unroll
        for (int jj = 0; jj < 2; ++jj) { const unsigned w[4] = {z2w[jj].x, z2w[jj].y, z2w[jj].z, z2w[jj].w};
#pragma unroll
            for (int e = 0; e < 4; ++e) { z[jj][2 * e] = __uint_as_float(w[e] << 16); z[jj][2 * e + 1] = __uint_as_float(w[e] & 0xffff0000u); s3 += z[jj][2 * e] * z[jj][2 * e] + z[jj][2 * e + 1] * z[jj][2 * e + 1]; } }
        const float rs3 = 1.0f / sqrtf(wave_sum(s3) * (1.f / D) + NORM_EPS);
#pragma unroll
        for (int jj = 0; jj < 2; ++jj) { const int eb = 8 * (64 * jj + lane);
#pragma unroll
            for (int hf = 0; hf < 2; ++hf) { f32x4 o;
#pragma unroll
                for (int e = 0; e < 4; ++e) o[e] = x[jj][hf][e] + z[jj][4 * hf + e] * rs3 * gb[jj][hf][e];
                *(GAS f32x4*)(orow + eb + 4 * hf) = o; } } }
}

__global__ void __launch_bounds__(NWAVES * 64, 2) fwd_kernel(Args args) {
    extern __shared__ __attribute__((aligned(16))) unsigned char lds[];
    Frame F;
    F.lds = (LAS unsigned char*)lds;
    F.MISC = (volatile LAS unsigned*)(F.lds + MISC_OFF);
    F.wave = __builtin_amdgcn_readfirstlane(threadIdx.x >> 6); F.lane = lane_fresh(); F.tid = (F.wave << 6) | F.lane;
    F.G = gridDim.x; { const int bx = blockIdx.x; F.vcu = (F.G % 8 == 0) ? (bx % 8) * (F.G / 8) + bx / 8 : bx; }
    const Args& A = args;
    F.ctl = (gu32*)(args.ws + WS_CTL);
    for (int u = F.tid; u < (LDS_BYTES - LDSCTL_OFF) / 4; u += NWAVES * 64) ((LAS unsigned*)(F.lds + LDSCTL_OFF))[u] = 0u;
    __syncthreads();
    XcdBarrier bar = xcd_barrier_post((unsigned*)(F.ctl + CW_BAR), F.MISC + 8);
#define GRID_BAR() xcd_barrier(bar)
    unsigned char* ws = args.ws;
    bf16* XN = (bf16*)(ws + WS_XN); bf16* QKV = (bf16*)(ws + WS_QKV); bf16* FB = (bf16*)(ws + WS_F); bf16* GATE = (bf16*)args.out; bf16* ACAT = (bf16*)(ws + WS_ACAT);
    bf16* MERGED = (bf16*)(ws + WS_MERGED); bf16* Z = (bf16*)(ws + WS_Z); bf16* HB = (bf16*)(ws + WS_H); bf16* Z2 = (bf16*)(ws + WS_Z2);

    p0_prologue<0>(F, A);
    GRID_BAR();
    { pg8::Gemm g{XN, (const bf16*)(ws + WS_WIN), M, NIN, D}; pg8::StaticOrder S; S.init(M, NIN, F.G, (int)blockIdx.x);
      pg8::EpiProj E{QKV, FB, GATE, A.in[7], QSCALE};
      pg8::gemm_phase<pg8::EpiProj, pg8::StaticOrder, true, true>(F.lds + RING_OFF, g, S, E, F.wave); }
    GRID_BAR();
    att::attn_phase(F.lds, QKV, (const float*)(ws + WS_SMALL), (bf16*)(ws + WS_OPART), (float*)(ws + WS_LSE), (int)blockIdx.x, F.G, F.wave);
    GRID_BAR();
    F.lane = lane_fresh(); F.tid = (F.wave << 6) | F.lane;
    xs_prepass(FB, A.in[8], (bf16*)(ws + WS_XS), (int)blockIdx.x * NWAVES * 64 + F.tid, F.G * NWAVES * 64);
    att::attn_combine((const bf16*)(ws + WS_OPART), (const float*)(ws + WS_LSE), ACAT, (int)blockIdx.x * NWAVES * 64 + F.tid, F.G * NWAVES * 64);
    GRID_BAR();
    F.lane = lane_fresh(); F.tid = (F.wave << 6) | F.lane;
    p0_prologue<1>(F, A);
    __syncthreads();
    { const int nW = F.G >= 256 ? 2 : 1;
      if (nW == 2) { if ((int)blockIdx.x < 256) rw::rwkv_chain(F.lds, A, (int)blockIdx.x & 127, F.wave, (int)blockIdx.x >> 7, 2); }
      else { for (int c = (int)blockIdx.x; c < 128; c += F.G) rw::rwkv_chain(F.lds, A, c, F.wave, 0, 1); } }
    GRID_BAR();
    { int kcat = 1280; asm volatile("" : "+s"(kcat));
      pg8::Gemm g{ACAT, (const bf16*)(ws + WS_WCAT), M, D, kcat}; pg8::StaticOrder S; S.init(M, D, F.G, (int)blockIdx.x);
      pg8::EpiMerge2 E{MERGED, GATE};
      pg8::gemm_phase<pg8::EpiMerge2, pg8::StaticOrder, true, true>(F.lds + RING_OFF, g, S, E, F.wave); }
    GRID_BAR();
    { pg8::Gemm g{MERGED, (const bf16*)(ws + WS_WO), M, D, D}; pg8::StaticOrder S; S.init(M, D, F.G, (int)blockIdx.x);
      pg8::EpiBf16Plain E{Z, D};
      pg8::gemm_phase<pg8::EpiBf16Plain, pg8::StaticOrder, true, true>(F.lds + RING_OFF, g, S, E, F.wave); }
    GRID_BAR();
    F.lane = lane_fresh(); F.tid = (F.wave << 6) | F.lane;
    { const int gw = F.vcu * NWAVES + F.wave, NGW = F.G * NWAVES;
      for (int m = gw; m < M; m += NGW) row_pass<0>(F.lane, A.in[0] + (size_t)m * D, Z + (size_t)m * D, A.in[3], A.in[4], XN + (size_t)m * D, nullptr, nullptr, nullptr); }
    GRID_BAR();
    { pg8::Gemm g{XN, (const bf16*)(ws + WS_W1), M, FF, D}; pg8::StaticOrder S; S.init(M, FF, F.G, (int)blockIdx.x);
      pg8::EpiRelu2 E{HB, FF};
      pg8::gemm_phase<pg8::EpiRelu2, pg8::StaticOrder, true, true>(F.lds + RING_OFF, g, S, E, F.wave); }
    GRID_BAR();
    { pg8::Gemm g{HB, (const bf16*)(ws + WS_W2), M, D, FF}; pg8::StaticOrder S; S.init(M, D, F.G, (int)blockIdx.x);
      pg8::EpiBf16Plain E{Z2, D};
      pg8::gemm_phase<pg8::EpiBf16Plain, pg8::StaticOrder, true, true>(F.lds + RING_OFF, g, S, E, F.wave); }
    GRID_BAR();
    F.lane = lane_fresh(); F.tid = (F.wave << 6) | F.lane;
    { const int gw = F.vcu * NWAVES + F.wave, NGW = F.G * NWAVES;
      for (int m = gw; m < M; m += NGW) row_pass<1>(F.lane, A.in[0] + (size_t)m * D, Z + (size_t)m * D, A.in[3], nullptr, nullptr, Z2 + (size_t)m * D, A.in[5], A.out + (size_t)m * D); }
}

extern "C" void kernel_launch(void* const* d_in, const int* in_sizes, int n_in, void* d_out, int out_size, void* d_ws, size_t ws_size, hipStream_t stream) {
    static int grid = 0;
    if (grid == 0) {
        if (n_in != NIN_T || out_size != M * D || ws_size < WS_END) { fprintf(stderr, "kernel_launch: unexpected shapes: n_in %d out %d ws %zu\n", n_in, out_size, ws_size); grid = -1; return; }
        int dev = 0, cus = 0, per_cu = 0;
        if (hipGetDevice(&dev) != hipSuccess || hipDeviceGetAttribute(&cus, hipDeviceAttributeMultiprocessorCount, dev) != hipSuccess) { grid = -1; return; }
        if (hipFuncSetAttribute((const void*)fwd_kernel, hipFuncAttributeMaxDynamicSharedMemorySize, LDS_BYTES) != hipSuccess) { fprintf(stderr, "kernel_launch: hipFuncSetAttribute failed\n"); grid = -1; return; }
        if (hipOccupancyMaxActiveBlocksPerMultiprocessor(&per_cu, (const void*)fwd_kernel, NWAVES * 64, LDS_BYTES) != hipSuccess || per_cu < 1) { fprintf(stderr, "kernel_launch: occupancy query says %d\n", per_cu); }
        (void)hipGetLastError();
        grid = cus;
    }
    if (grid < 0) return;
    if (hipMemsetAsync((char*)d_ws + WS_CTL, 0, CTL_ZERO_BYTES, stream) != hipSuccess) { fprintf(stderr, "kernel_launch: memset failed\n"); return; }
    Args a{};
    for (int i = 0; i < NIN_T; ++i) a.in[i] = (const float*)d_in[i];
    a.out = (float*)d_out; a.ws = (unsigned char*)d_ws;
    hipLaunchKernelGGL(fwd_kernel, dim3(grid), dim3(NWAVES * 64), LDS_BYTES, stream, a);
}
```
